# Optimizing an MI355X kernel written in HIP

```python
import jax, jax.numpy as jnp
from jax import lax
import numpy as np

D_MODEL = 1024
BATCH = 8
SEQ = 8192
DEPTH = 2

NORM_EPS = 1e-6
HEAD_DIM = 64
MIX_WIDTH = D_MODEL
GROUP_WIDTH = MIX_WIDTH // 4
A_HEADS = GROUP_WIDTH // HEAD_DIM
A_WIDTH = A_HEADS * HEAD_DIM
MOBA_BLOCK = 256
MOBA_TOPK = 3
MOBA_QCHUNK = 64
POOL_WINDOWS = (2, 4, 8, 16)
POOL_GROUPS = 4
B_WIDTH = GROUP_WIDTH
POOL_GROUP_DIM = B_WIDTH // POOL_GROUPS
C_HEADS = GROUP_WIDTH // HEAD_DIM
C_KV_HEADS = C_HEADS // 2
C_WIDTH = C_HEADS * HEAD_DIM
C_KV_WIDTH = C_KV_HEADS * HEAD_DIM
SWA_WINDOW = 128
SWA_BLOCK = 128
D_WIDTH = GROUP_WIDTH
CONV_WIDTH = 3
PROJ_SIZES = (A_WIDTH, A_WIDTH, A_WIDTH, A_WIDTH,
              B_WIDTH, B_WIDTH,
              C_WIDTH, C_KV_WIDTH, C_KV_WIDTH, C_WIDTH,
              D_WIDTH, D_WIDTH, D_WIDTH, D_WIDTH)
IN_PROJ_WIDTH = 4 * A_WIDTH + 2 * B_WIDTH + 2 * C_WIDTH + 2 * C_KV_WIDTH + 4 * D_WIDTH

kernel_name = "hymba_style_moba_pool_swa_conv_hybrid"


def rms_norm(x, gain):
    xf = x.astype(jnp.float32)
    y = xf * lax.rsqrt(jnp.mean(xf * xf, axis=-1, keepdims=True) + NORM_EPS)
    return (y * gain.astype(jnp.float32)).astype(x.dtype)


def alibi_slopes(n):
    return jnp.exp2(-(8.0 / n) * jnp.arange(1, n + 1, dtype=jnp.float32))


def moba_attention(q, k, v, slopes):
    B, H, S, Dh = q.shape
    nb = max(-(-S // MOBA_BLOCK), MOBA_TOPK)
    pad = nb * MOBA_BLOCK - S
    kb = jnp.pad(k, ((0, 0), (0, 0), (0, pad), (0, 0))).reshape(B, H, nb, MOBA_BLOCK, Dh)
    vb = jnp.pad(v, ((0, 0), (0, 0), (0, pad), (0, 0))).reshape(B, H, nb, MOBA_BLOCK, Dh)
    kmean = jnp.mean(kb.astype(jnp.float32), axis=3)
    nq = S // MOBA_QCHUNK
    qc = q.reshape(B, H, nq, MOBA_QCHUNK, Dh).transpose(2, 0, 1, 3, 4)
    scale = Dh ** -0.5
    bidx = jnp.arange(B)[:, None, None, None]
    hidx = jnp.arange(H)[None, :, None, None]
    sl = slopes.astype(jnp.float32)

    def one_chunk(args):
        qi, c = args
        t0 = c * MOBA_QCHUNK
        own = t0 // MOBA_BLOCK
        tq = t0 + jnp.arange(MOBA_QCHUNK)
        qf = qi.astype(jnp.float32)
        bscore = jnp.einsum('bhqd,bhnd->bhqn', qf, kmean)
        bscore = jnp.where(jnp.arange(nb) < own, bscore, -jnp.inf)
        _, idx = lax.top_k(bscore, MOBA_TOPK)
        sel_valid = jnp.arange(MOBA_TOPK) < own
        ksel = kb[bidx, hidx, idx].astype(jnp.float32)
        vsel = vb[bidx, hidx, idx].astype(jnp.float32)
        kpos = idx[..., None] * MOBA_BLOCK + jnp.arange(MOBA_BLOCK)
        dsel = (tq[None, None, :, None, None] - kpos).astype(jnp.float32)
        s_sel = jnp.einsum('bhqd,bhqjkd->bhqjk', qf, ksel) * scale - sl[None, :, None, None, None] * dsel
        s_sel = jnp.where(sel_valid[:, None], s_sel, -jnp.inf)
        s_sel = s_sel.reshape(B, H, MOBA_QCHUNK, MOBA_TOPK * MOBA_BLOCK)
        kown = lax.dynamic_index_in_dim(kb, own, axis=2, keepdims=False).astype(jnp.float32)
        vown = lax.dynamic_index_in_dim(vb, own, axis=2, keepdims=False).astype(jnp.float32)
        dist = tq[:, None] - (own * MOBA_BLOCK + jnp.arange(MOBA_BLOCK))[None, :]
        s_own = jnp.einsum('bhqd,bhkd->bhqk', qf, kown) * scale - sl[None, :, None, None] * dist.astype(jnp.float32)
        s_own = jnp.where(dist >= 0, s_own, -jnp.inf)
        p = jax.nn.softmax(jnp.concatenate([s_sel, s_own], axis=-1), axis=-1)
        p_sel = p[..., :MOBA_TOPK * MOBA_BLOCK].reshape(B, H, MOBA_QCHUNK, MOBA_TOPK, MOBA_BLOCK)
        p_own = p[..., MOBA_TOPK * MOBA_BLOCK:]
        out = (jnp.einsum('bhqjk,bhqjkd->bhqd', p_sel, vsel)
               + jnp.einsum('bhqk,bhkd->bhqd', p_own, vown))
        return out.astype(q.dtype)

    out = lax.map(one_chunk, (qc, jnp.arange(nq)))
    return out.transpose(1, 2, 0, 3, 4).reshape(B, H, S, Dh)


def swa_attention(q, k, v, sinks, slopes):
    B, Hq, S, Dh = q.shape
    Hkv = k.shape[1]
    G = Hq // Hkv
    W = SWA_BLOCK
    nblk = S // W
    qb = q.reshape(B, Hkv, G, nblk, W, Dh).astype(jnp.float32)
    kb = k.reshape(B, Hkv, nblk, W, Dh).astype(jnp.float32)
    vb = v.reshape(B, Hkv, nblk, W, Dh).astype(jnp.float32)
    kk = jnp.concatenate([jnp.pad(kb, ((0, 0), (0, 0), (1, 0), (0, 0), (0, 0)))[:, :, :-1], kb], axis=3)
    vv = jnp.concatenate([jnp.pad(vb, ((0, 0), (0, 0), (1, 0), (0, 0), (0, 0)))[:, :, :-1], vb], axis=3)
    s = jnp.einsum('bkgnqd,bkncd->bkgnqc', qb, kk) * (Dh ** -0.5)
    kpos = jnp.arange(2 * W) - W
    dist = jnp.arange(W)[:, None] - kpos[None, :]
    mask = ((dist >= 0) & (dist < SWA_WINDOW))[None] & ((jnp.arange(nblk)[:, None, None] > 0) | (kpos[None, None, :] >= 0))
    sl = slopes.astype(jnp.float32).reshape(Hkv, G)
    s = s - sl[None, :, :, None, None, None] * dist.astype(jnp.float32)
    s = jnp.where(mask, s, -jnp.inf)
    sink = jnp.broadcast_to(sinks.astype(jnp.float32).reshape(Hkv, G)[None, :, :, None, None, None], s.shape[:-1] + (1,))
    p = jax.nn.softmax(jnp.concatenate([s, sink], axis=-1), axis=-1)[..., :2 * W]
    o = jnp.einsum('bkgnqc,bkncd->bkgnqd', p, vv)
    return o.reshape(B, Hq, S, Dh).astype(q.dtype)


def multiscale_pool(u):
    S = u.shape[1]
    uf = u.astype(jnp.float32)
    cs = jnp.cumsum(uf, axis=1)
    pos = jnp.arange(S)
    outs = []
    for gi, w in enumerate(POOL_WINDOWS):
        c = cs[..., gi * POOL_GROUP_DIM:(gi + 1) * POOL_GROUP_DIM]
        shifted = jnp.pad(c, ((0, 0), (w, 0), (0, 0)))[:, :S]
        cnt = jnp.minimum(pos + 1, w).astype(jnp.float32)[None, :, None]
        outs.append((c - shifted) / cnt)
    return (jnp.concatenate(outs, axis=-1) - uf).astype(u.dtype)


def short_conv(u, w):
    C = u.shape[-1]
    return lax.conv_general_dilated(u, w[:, None, :].astype(u.dtype), window_strides=(1,),
                                    padding=((CONV_WIDTH - 1, 0),),
                                    dimension_numbers=('NWC', 'WIO', 'NWC'),
                                    feature_group_count=C)


def hybrid_layer(x, norm_g, w_in, w_out, a_qn, a_kn, pool_w, pool_scale, c_qn, c_kn, c_sinks, conv_w, slopes_a, slopes_c):
    B, S, _ = x.shape
    h = rms_norm(x, norm_g)
    proj = h @ w_in.astype(h.dtype)
    split_points = [int(p) for p in np.cumsum(PROJ_SIZES)[:-1]]
    aq, ak, av, ag, bu, bg, cq, ck, cv, cg, dh, db, dc, dg = jnp.split(proj, split_points, axis=-1)

    def to_heads(t):
        return t.reshape(B, S, -1, HEAD_DIM).transpose(0, 2, 1, 3)

    def from_heads(t):
        return t.transpose(0, 2, 1, 3).reshape(B, S, -1)

    ya = moba_attention(rms_norm(to_heads(aq), a_qn), rms_norm(to_heads(ak), a_kn), to_heads(av), slopes_a)
    ya = from_heads(ya) * jax.nn.silu(ag)
    pooled = multiscale_pool(bu).reshape(B, S, POOL_GROUPS, POOL_GROUP_DIM)
    yb = jnp.einsum('bsgc,gcd->bsgd', pooled, pool_w.astype(pooled.dtype)).reshape(B, S, B_WIDTH)
    yb = yb * pool_scale * jax.nn.silu(bg)
    yc = swa_attention(rms_norm(to_heads(cq), c_qn), rms_norm(to_heads(ck), c_kn), to_heads(cv), c_sinks, slopes_c)
    yc = from_heads(yc) * jax.nn.silu(cg)
    yd = db * short_conv(dc * dh, conv_w) * jax.nn.silu(dg)

    y = jnp.concatenate([ya, yb, yc, yd], axis=-1) @ w_out.astype(x.dtype)
    return x + y


def setup_inputs(seed: int = 0) -> dict:
    key = jax.random.key(seed)
    ks = jax.random.split(key, 14)
    f32 = jnp.float32
    nrm = lambda k, s: jax.random.normal(k, s, dtype=f32)
    return {
        "x": nrm(ks[0], (BATCH, SEQ, D_MODEL)),
        "norm_g": 1.0 + 0.02 * nrm(ks[1], (DEPTH, D_MODEL)),
        "w_in": nrm(ks[2], (DEPTH, D_MODEL, IN_PROJ_WIDTH)) * D_MODEL ** -0.5,
        "w_out": nrm(ks[3], (DEPTH, MIX_WIDTH, D_MODEL)) * MIX_WIDTH ** -0.5,
        "a_q_norm": 1.0 + 0.02 * nrm(ks[4], (DEPTH, HEAD_DIM)),
        "a_k_norm": 1.0 + 0.02 * nrm(ks[5], (DEPTH, HEAD_DIM)),
        "pool_w": nrm(ks[6], (DEPTH, POOL_GROUPS, POOL_GROUP_DIM, POOL_GROUP_DIM)) * POOL_GROUP_DIM ** -0.5,
        "pool_scale": 1.0 + 0.1 * nrm(ks[7], (DEPTH, B_WIDTH)),
        "c_q_norm": 1.0 + 0.02 * nrm(ks[8], (DEPTH, HEAD_DIM)),
        "c_k_norm": 1.0 + 0.02 * nrm(ks[9], (DEPTH, HEAD_DIM)),
        "c_sinks": nrm(ks[10], (DEPTH, C_HEADS)),
        "conv_w": nrm(ks[11], (DEPTH, CONV_WIDTH, D_WIDTH)) * CONV_WIDTH ** -0.5,
    }


def reference(x, norm_g, w_in, w_out, a_q_norm, a_k_norm, pool_w, pool_scale, c_q_norm, c_k_norm, c_sinks, conv_w):
    slopes = alibi_slopes(A_HEADS + C_HEADS)
    slopes_c = slopes[:C_HEADS]
    slopes_a = slopes[C_HEADS:]
    for l in range(DEPTH):
        x = hybrid_layer(x, norm_g[l], w_in[l], w_out[l], a_q_norm[l], a_k_norm[l],
                         pool_w[l], pool_scale[l], c_q_norm[l], c_k_norm[l], c_sinks[l],
                         conv_w[l], slopes_a, slopes_c)
    return x
```

```cpp
#include <hip/hip_runtime.h>
#include <cstdio>
#include <cstdint>
#include <cmath>
namespace pg8 {
#define PG8_LAS __attribute__((address_space(3)))
typedef unsigned short bf16_t;
typedef short bf16x8 __attribute__((ext_vector_type(8)));
typedef float f32x4 __attribute__((ext_vector_type(4)));
typedef unsigned u32x4 __attribute__((ext_vector_type(4)));
constexpr int BM = 256, BK = 64, HALF = 128, HTB = HALF * BK * 2  , STAGE_BYTES = 8 * HTB, NXCD = 8, WGM = 8;

__host__ __device__ __forceinline__ int lds_byte(int r, int c) { const int st = (r >> 4) * 2 + (c >> 5), rr = r & 15, cc = c & 31, ob = rr * 64 + cc * 2; return st * 1024 + (ob ^ (((ob >> 9) & 1) << 5)); }
__host__ __device__ __forceinline__ void stage_rc(int b, int& R, int& C) { const int st = b / 1024, sb = b % 1024, swz = sb ^ (((sb >> 9) & 1) << 5); R = (st >> 1) * 16 + swz / 64; C = (st & 1) * 32 + (swz % 64) / 2; }
__host__ __device__ __forceinline__ int perm32(int rho) { const int n = rho >> 4, i = rho & 15; return 8 * (i >> 2) + 4 * n + (i & 3); }

struct Unit { int pm, pn; };
struct Gemm { const bf16_t* A; const bf16_t* Bt; int M, N, K; };

struct StaticOrder {
    int nM, nN, nwg, G, c;
    __host__ __device__ void init(int M, int N, int G_, int c_) { nM = M / BM; nN = N / BM; nwg = nM * nN; G = G_; c = c_; }
    __host__ __device__ bool next(int i, Unit& u) const {
        const long L = (long)i * G + c; if (L >= nwg) return false;
        int wgid = (int)L; { const int q = nwg / NXCD, r = nwg % NXCD, xcd = wgid % NXCD, off = wgid / NXCD; wgid = (xcd < r ? xcd * (q + 1) : r * (q + 1) + (xcd - r) * q) + off; }
        const int nig = WGM * nN, gid = wgid / nig, fm = gid * WGM, gsz = (nM - fm) < WGM ? (nM - fm) : WGM;
        u.pm = fm + ((wgid % nig) % gsz); u.pn = (wgid % nig) / gsz; return true;
    }
    __device__ __forceinline__ void a_ready(const Unit&) const {}
    __device__ __forceinline__ void done(const Unit&) const {}
};

__device__ __forceinline__ unsigned cvt_pk_bf16(float lo, float hi) { unsigned r; asm volatile("v_cvt_pk_bf16_f32 %0, %1, %2" : "=v"(r) : "v"(lo), "v"(hi)); return r; }
typedef float f32x2 __attribute__((ext_vector_type(2)));
constexpr float QK_C2 = 0.125f * 1.4426950408889634f;
struct EpiInProj {
    static constexpr bool PERM = true, AFTER_DRAIN = false;
    bf16_t* P; const float* ssq; const float* qn_a; const float* kn_a; const float* qn_c; const float* kn_c; float* kmean;
    __device__ __forceinline__ void operator()(const f32x4 (&acc)[2][2][4][2], const Unit& u, int wr, int wc, int fr, int fq) const {
        const int pn = u.pn;
        const float* g = nullptr; float post = 1.f; bool silu = false, km = false;
        if (pn == 0) { g = qn_a; post = QK_C2; } else if (pn == 1) { g = kn_a; km = true; } else if (pn == 6) { g = qn_c; post = QK_C2; }
        else if (pn == 7) { if (wc < 2) g = kn_c; } else if (pn == 3 || pn == 5 || pn == 8 || pn == 12) silu = true;
        float scl[2][4];
#pragma unroll
        for (int ai = 0; ai < 2; ++ai)
#pragma unroll
            for (int m = 0; m < 4; ++m) {
                const int r = u.pm * BM + ai * HALF + wr * 64 + m * 16 + fr;
                float sr = __builtin_amdgcn_rsqf(ssq[r] * (1.0f / 1024.0f) + 1e-6f);
                if (g) { float ss = 0.f;
#pragma unroll
                    for (int bj = 0; bj < 2; ++bj)
#pragma unroll
                        for (int n = 0; n < 2; ++n) { const f32x4 q = acc[ai][bj][m][n] * acc[ai][bj][m][n]; ss += (q[0] + q[1]) + (q[2] + q[3]); }
                    ss += __shfl_xor(ss, 16); ss += __shfl_xor(ss, 32);
                    sr = sr * post * __builtin_amdgcn_rsqf(ss * sr * sr * (1.0f / 64.0f) + 1e-6f); }
                scl[ai][m] = sr; }
        const int lcol = pn * 256 + 64 * wc + 8 * fq;
#pragma unroll
        for (int bj = 0; bj < 2; ++bj) {
            f32x4 g0 = (f32x4){1.f, 1.f, 1.f, 1.f}, g1 = g0, cs0 = (f32x4){0.f, 0.f, 0.f, 0.f}, cs1 = cs0;
            if (g) { g0 = *(const f32x4*)(g + 32 * bj + 8 * fq); g1 = *(const f32x4*)(g + 32 * bj + 8 * fq + 4); }
#pragma unroll
            for (int ai = 0; ai < 2; ++ai)
#pragma unroll
                for (int m = 0; m < 4; ++m) {
                    const int r = u.pm * BM + ai * HALF + wr * 64 + m * 16 + fr;
                    f32x4 v0 = acc[ai][bj][m][0] * scl[ai][m] * g0, v1 = acc[ai][bj][m][1] * scl[ai][m] * g1;
                    if (silu) {
#pragma unroll
                        for (int e = 0; e < 4; ++e) { v0[e] = v0[e] * __builtin_amdgcn_rcpf(1.0f + __builtin_amdgcn_exp2f(-1.4426950408889634f * v0[e])); v1[e] = v1[e] * __builtin_amdgcn_rcpf(1.0f + __builtin_amdgcn_exp2f(-1.4426950408889634f * v1[e])); } }
                    if (km) { cs0 += v0; cs1 += v1; }
                    u32x4 w; w.x = cvt_pk_bf16(v0[0], v0[1]); w.y = cvt_pk_bf16(v0[2], v0[3]); w.z = cvt_pk_bf16(v1[0], v1[1]); w.w = cvt_pk_bf16(v1[2], v1[3]);
                    *(u32x4*)(P + (size_t)r * 3328 + lcol + 32 * bj) = w; }
            if (km) {
                float* kmp = kmean + ((size_t)((u.pm >> 5) * 4 + wc) * 32 + (u.pm & 31)) * 64 + 32 * bj + 8 * fq;
#pragma unroll
                for (int e = 0; e < 8; ++e) { float s = e < 4 ? cs0[e & 3] : cs1[e & 3]; s += __shfl_xor(s, 1); s += __shfl_xor(s, 2); s += __shfl_xor(s, 4); s += __shfl_xor(s, 8);
                    if (fr == 0) atomicAdd(kmp + e, s * (1.0f / 256.0f)); } }
        }
    }
};
struct EpiOutProj {
    static constexpr bool PERM = true, AFTER_DRAIN = false;
    const float* xin; float* xout; bf16_t* xb; float* ssq;
    __device__ __forceinline__ void operator()(const f32x4 (&acc)[2][2][4][2], const Unit& u, int wr, int wc, int fr, int fq) const {
        const int col0 = u.pn * BM + wc * 32 + 8 * fq;
#pragma unroll
        for (int ai = 0; ai < 2; ++ai)
#pragma unroll
            for (int m = 0; m < 4; ++m) {
                const int r = u.pm * BM + ai * HALF + wr * 64 + m * 16 + fr; const size_t off = (size_t)r * 1024 + col0; float ss = 0.f;
#pragma unroll
                for (int bj = 0; bj < 2; ++bj) { const f32x4 r0 = *(const f32x4*)(xin + off + bj * HALF), r1 = *(const f32x4*)(xin + off + bj * HALF + 4);
                    const f32x4 v0 = acc[ai][bj][m][0] + r0, v1 = acc[ai][bj][m][1] + r1;
                    *(f32x4*)(xout + off + bj * HALF) = v0; *(f32x4*)(xout + off + bj * HALF + 4) = v1;
                    if (xb) { u32x4 w; w.x = cvt_pk_bf16(v0[0], v0[1]); w.y = cvt_pk_bf16(v0[2], v0[3]); w.z = cvt_pk_bf16(v1[0], v1[1]); w.w = cvt_pk_bf16(v1[2], v1[3]); *(u32x4*)(xb + off + bj * HALF) = w;
                        const f32x4 q0 = v0 * v0, q1 = v1 * v1; ss += ((q0[0] + q0[1]) + (q0[2] + q0[3])) + ((q1[0] + q1[1]) + (q1[2] + q1[3])); } }
                if (xb) { ss += __shfl_xor(ss, 16); ss += __shfl_xor(ss, 32); if (fq == 0) atomicAdd(ssq + r, ss); }
            }
    }
};
template <class Epi, class Sched, bool ALIGN_EPI = false, bool SP2 = false>
__device__ __forceinline__ void gemm_phase(PG8_LAS unsigned char* lds, const Gemm g, const Sched& S, const Epi& E) {
    int tid_ = threadIdx.x; asm volatile("" : "+v"(tid_));
    const int tid = tid_, wid = __builtin_amdgcn_readfirstlane(tid >> 6), lane = tid & 63, wr = wid >> 2, wc = wid & 3, fr = lane & 15, fq = lane >> 4;
    const int K = g.K, nt = K / BK;
    unsigned voffA[2], voffB[2];
#pragma unroll
    for (int i = 0; i < 2; ++i) { int R, C; stage_rc(tid * 16 + i * 8192, R, C); const int Rb = Epi::PERM ? ((R & ~31) + perm32(R & 31)) : R;
        voffA[i] = (unsigned)(R * K + C) * 2u; voffB[i] = (unsigned)(Rb * K + C) * 2u; }
    const size_t kstep = (size_t)(BK * 2);
    const size_t hstep = (size_t)HALF * K * 2;
    const size_t tstep = 2 * hstep;
    const unsigned ldsw = (unsigned)wid * 1024u;
    const int aoff = lds_byte(wr * 64 + fr, fq * 8), boff = lds_byte(wc * 32 + fr, fq * 8);
#define PG8_SA(b, h) (((b) * 2 + (h)) * HTB)
#define PG8_SB(b, h) ((4 + (b) * 2 + (h)) * HTB)
#define PG8_STAGE(bufoff, gbase, voff) do { _Pragma("unroll") for (int _i = 0; _i < 2; ++_i) \
        __builtin_amdgcn_global_load_lds((const unsigned*)((const char*)(gbase) + (voff)[_i]), (PG8_LAS unsigned*)(lds + (bufoff) + ldsw + _i * 8192), 16, 0, 0); } while (0)
#define PG8_LDA(dst, b, h) do { _Pragma("unroll") for (int m = 0; m < 4; ++m) _Pragma("unroll") for (int k = 0; k < 2; ++k) dst[m][k] = *(const PG8_LAS bf16x8*)(lds + PG8_SA(b, h) + aoff + m * 2048 + k * 1024); } while (0)
#define PG8_LDB(dst, b, h) do { _Pragma("unroll") for (int n = 0; n < 2; ++n) _Pragma("unroll") for (int k = 0; k < 2; ++k) dst[n][k] = *(const PG8_LAS bf16x8*)(lds + PG8_SB(b, h) + boff + n * 2048 + k * 1024); } while (0)
#define PG8_MMA(ai, bj, At, Bt) do { __builtin_amdgcn_s_setprio(1); _Pragma("unroll") for (int m = 0; m < 4; ++m) _Pragma("unroll") for (int n = 0; n < 2; ++n) _Pragma("unroll") for (int k = 0; k < 2; ++k) \
        acc[ai][bj][m][n] = __builtin_amdgcn_mfma_f32_16x16x32_bf16(Bt[n][k], At[m][k], acc[ai][bj][m][n], 0, 0, 0); __builtin_amdgcn_s_setprio(0); } while (0)
#define PG8_WAIT_V(n) asm volatile("s_waitcnt vmcnt(" #n ")" ::: "memory")
#define PG8_WAIT_L(n) asm volatile("s_waitcnt lgkmcnt(" #n ")" ::: "memory")
#define PG8_BAR __builtin_amdgcn_s_barrier()
#define PG8_SCHED __builtin_amdgcn_sched_barrier(0)
    Unit cur, nxt; int ui = 0;
    if (!S.next(0, cur)) return;
    f32x4 acc[2][2][4][2];
#pragma unroll
    for (int a = 0; a < 2; ++a)
#pragma unroll
        for (int b = 0; b < 2; ++b)
#pragma unroll
            for (int m = 0; m < 4; ++m)
#pragma unroll
                for (int n = 0; n < 2; ++n) acc[a][b][m][n] = (f32x4){0.f, 0.f, 0.f, 0.f};
    bf16x8 At[4][2], B0[2][2], B1[2][2];
    const char* cA = (const char*)g.A + (size_t)cur.pm * tstep; const char* cB = (const char*)g.Bt + (size_t)cur.pn * tstep;
    S.a_ready(cur);
    if constexpr (SP2) {
        PG8_STAGE(PG8_SB(0, 0), cB, voffB); PG8_STAGE(PG8_SB(0, 1), cB + hstep, voffB); PG8_STAGE(PG8_SA(0, 0), cA, voffA); PG8_STAGE(PG8_SA(0, 1), cA + hstep, voffA);
        if (wr == 1) PG8_BAR;
        PG8_WAIT_V(2); PG8_BAR;
        PG8_STAGE(PG8_SB(1, 0), cB + kstep, voffB); PG8_STAGE(PG8_SA(1, 0), cA + kstep, voffA); PG8_STAGE(PG8_SB(1, 1), cB + hstep + kstep, voffB);
        PG8_WAIT_V(6); PG8_BAR;
    } else {
        PG8_STAGE(PG8_SB(0, 0), cB, voffB); PG8_STAGE(PG8_SA(0, 0), cA, voffA); PG8_STAGE(PG8_SB(0, 1), cB + hstep, voffB); PG8_STAGE(PG8_SA(0, 1), cA + hstep, voffA);
        if (wr == 1) PG8_BAR;
        PG8_WAIT_V(4); PG8_BAR;
        PG8_STAGE(PG8_SB(1, 0), cB + kstep, voffB); PG8_STAGE(PG8_SA(1, 0), cA + kstep, voffA); PG8_STAGE(PG8_SB(1, 1), cB + hstep + kstep, voffB);
        PG8_WAIT_V(6); PG8_BAR;
    }
    for (;;) {
        const bool has_next = S.next(ui + 1, nxt);
        const char* nA = has_next ? (const char*)g.A + (size_t)nxt.pm * tstep : cA; const char* nB = has_next ? (const char*)g.Bt + (size_t)nxt.pn * tstep : cB;
        for (int t = 0; t < nt; t += 2) {
            const bool last = (t == nt - 2);
            const char* a1 = cA + (size_t)(t + 1) * kstep;
            const char* a2 = last ? nA : cA + (size_t)(t + 2) * kstep; const char* b2 = last ? nB : cB + (size_t)(t + 2) * kstep;
            const char* a3 = a2 + kstep; const char* b3 = b2 + kstep;
            if (last && has_next) S.a_ready(nxt);
            if constexpr (SP2) {
            PG8_LDB(B0, 0, 0); PG8_LDB(B1, 0, 1); PG8_SCHED; PG8_LDA(At, 0, 0); PG8_STAGE(PG8_SA(1, 1), a1 + hstep, voffA);
            PG8_WAIT_V(8); PG8_WAIT_L(0); PG8_BAR; PG8_MMA(0, 0, At, B0); PG8_MMA(0, 1, At, B1); PG8_BAR; PG8_SCHED;
            PG8_LDA(At, 0, 1); PG8_STAGE(PG8_SB(0, 0), b2, voffB); PG8_STAGE(PG8_SB(0, 1), b2 + hstep, voffB); PG8_STAGE(PG8_SA(0, 0), a2, voffA);
            PG8_WAIT_V(8); PG8_WAIT_L(0); PG8_BAR; PG8_MMA(1, 0, At, B0); PG8_MMA(1, 1, At, B1); PG8_BAR; PG8_SCHED;
            PG8_LDB(B0, 1, 0); PG8_LDB(B1, 1, 1); PG8_SCHED; PG8_LDA(At, 1, 0); PG8_STAGE(PG8_SA(0, 1), a2 + hstep, voffA);
            PG8_WAIT_V(8); PG8_WAIT_L(0); PG8_BAR; PG8_MMA(0, 0, At, B0); PG8_MMA(0, 1, At, B1); PG8_BAR; PG8_SCHED;
            PG8_LDA(At, 1, 1); PG8_STAGE(PG8_SB(1, 0), b3, voffB); PG8_STAGE(PG8_SB(1, 1), b3 + hstep, voffB); PG8_STAGE(PG8_SA(1, 0), a3, voffA);
            PG8_WAIT_V(8); PG8_WAIT_L(0); PG8_BAR; PG8_MMA(1, 0, At, B0); PG8_MMA(1, 1, At, B1); PG8_BAR; PG8_SCHED;
            } else {
            PG8_LDB(B0, 0, 0); PG8_SCHED; PG8_LDA(At, 0, 0); PG8_STAGE(PG8_SA(1, 1), a1 + hstep, voffA);
            PG8_WAIT_L(8); PG8_BAR; PG8_WAIT_L(0); PG8_MMA(0, 0, At, B0); PG8_BAR; PG8_SCHED;
            PG8_LDB(B1, 0, 1); PG8_STAGE(PG8_SB(0, 0), b2, voffB);
            PG8_BAR; PG8_WAIT_L(0); PG8_MMA(0, 1, At, B1); PG8_BAR;
            PG8_LDA(At, 0, 1); PG8_STAGE(PG8_SA(0, 0), a2, voffA);
            PG8_BAR; PG8_WAIT_L(0); PG8_MMA(1, 0, At, B0); PG8_BAR; PG8_SCHED;
            PG8_STAGE(PG8_SB(0, 1), b2 + hstep, voffB);
            PG8_WAIT_V(6); PG8_BAR; PG8_MMA(1, 1, At, B1); PG8_BAR;
            PG8_LDB(B0, 1, 0); PG8_SCHED; PG8_LDA(At, 1, 0); PG8_STAGE(PG8_SA(0, 1), a2 + hstep, voffA);
            PG8_WAIT_L(8); PG8_BAR; PG8_WAIT_L(0); PG8_MMA(0, 0, At, B0); PG8_BAR; PG8_SCHED;
            PG8_LDB(B1, 1, 1); PG8_STAGE(PG8_SB(1, 0), b3, voffB);
            PG8_BAR; PG8_WAIT_L(0); PG8_MMA(0, 1, At, B1); PG8_BAR;
            PG8_LDA(At, 1, 1); PG8_STAGE(PG8_SA(1, 0), a3, voffA);
            PG8_BAR; PG8_WAIT_L(0); PG8_MMA(1, 0, At, B0); PG8_BAR; PG8_SCHED;
            PG8_STAGE(PG8_SB(1, 1), b3 + hstep, voffB);
            PG8_WAIT_V(6); PG8_BAR; PG8_MMA(1, 1, At, B1); PG8_BAR;
            }
        }
        if constexpr (ALIGN_EPI) { if (wr == 0) PG8_BAR; }
        if constexpr (!Epi::AFTER_DRAIN) { E(acc, cur, wr, wc, fr, fq); S.done(cur); }
        if (!has_next) break;
#pragma unroll
        for (int a = 0; a < 2; ++a)
#pragma unroll
            for (int b = 0; b < 2; ++b)
#pragma unroll
                for (int m = 0; m < 4; ++m)
#pragma unroll
                    for (int n = 0; n < 2; ++n) acc[a][b][m][n] = (f32x4){0.f, 0.f, 0.f, 0.f};
        cur = nxt; cA = nA; cB = nB; ++ui;
        if constexpr (ALIGN_EPI) { if (wr == 1) PG8_BAR; }
    }
    PG8_WAIT_V(0);
    if constexpr (!ALIGN_EPI) { if (wr == 0) PG8_BAR; }
    PG8_BAR;
    if constexpr (Epi::AFTER_DRAIN) { E.fused(acc, cur, wr, wc, fr, fq, lds, wid, lane); S.done(cur); }
#undef PG8_SA
#undef PG8_SB
#undef PG8_STAGE
#undef PG8_LDA
#undef PG8_LDB
#undef PG8_MMA
#undef PG8_WAIT_V
#undef PG8_WAIT_L
#undef PG8_BAR
#undef PG8_SCHED
}
}
#define GAS __attribute__((address_space(1)))
#define LAS __attribute__((address_space(3)))
typedef unsigned short bf16;
typedef unsigned v4u __attribute__((ext_vector_type(4)));
typedef float f32x4 __attribute__((ext_vector_type(4)));
typedef short bf16x8 __attribute__((ext_vector_type(8)));
typedef GAS unsigned gu32;
typedef GAS unsigned long long gu64;
#define RLX_AGENT __ATOMIC_RELAXED, __HIP_MEMORY_SCOPE_AGENT
#define LDS_WAIT() asm volatile("s_waitcnt lgkmcnt(0)" ::: "memory")
#define VM_WAIT() asm volatile("s_waitcnt vmcnt(0)" ::: "memory")
__device__ __forceinline__ unsigned long long rt() { return __builtin_amdgcn_s_memrealtime(); }
__device__ __forceinline__ unsigned f2bf(float f) { unsigned u = __builtin_bit_cast(unsigned, f); return (u + 0x7fffu + ((u >> 16) & 1u)) >> 16; }
__device__ __forceinline__ unsigned pk2(float lo, float hi) { return f2bf(lo) | (f2bf(hi) << 16); }

#define XB_TMO      128
#define XB_XCNT(j)  (256  + 64 * (j))
#define XB_XSUB(j)  (1280 + 64 * (j))
#define XB_XGEN(j)  (2304 + 64 * (j))
#define XB_TOP      3328
#define XB_TOPGEN   3392
#define XCD_BAR_WORDS 3456
#define XB_SPIN_CAP (1u << 18)

__device__ __forceinline__ unsigned xb_ld(unsigned* p)              { return __hip_atomic_load(p, __ATOMIC_RELAXED, __HIP_MEMORY_SCOPE_AGENT); }
__device__ __forceinline__ unsigned xb_add(unsigned* p, unsigned v) { return __hip_atomic_fetch_add(p, v, __ATOMIC_RELAXED, __HIP_MEMORY_SCOPE_AGENT); }
__device__ __forceinline__ unsigned xb_xcc_id() { return (unsigned)__builtin_amdgcn_s_getreg((3 << 11) | 20) & 0xFu; }
#define XB_SPIN(cond, bar) do { unsigned _sp = 0; while (cond) { __builtin_amdgcn_s_sleep(1); \
    if ((++_sp & 255u) == 0u) { if (xb_ld(&(bar)[XB_TMO])) break; if (_sp > XB_SPIN_CAP) { atomicAdd(&(bar)[XB_TMO], 1u); break; } } } } while (0)

struct XcdBarrier {
    unsigned* bar; unsigned x;
    volatile LAS unsigned* st;
};

__device__ __forceinline__ XcdBarrier xcd_barrier_post(unsigned* bar, volatile LAS unsigned* st) {
    XcdBarrier b; b.bar = bar; b.x = xb_xcc_id(); b.st = st;
    if (threadIdx.x == 0) (void)xb_add(&bar[XB_XCNT(b.x)], 1u);
    return b;
}
__device__ __forceinline__ void xcd_barrier_complete(unsigned* bar, unsigned x, unsigned& nloc, unsigned& nx) {
    const unsigned G = gridDim.x * gridDim.y * gridDim.z;
    unsigned sum, cnt, mine, sp = 0u;
    for (;;) {
        sum = 0u; cnt = 0u; mine = 0u;
#pragma unroll
        for (unsigned j = 0; j < 16; ++j) { const unsigned c = xb_ld(&bar[XB_XCNT(j)]); sum += c; cnt += (c > 0u) ? 1u : 0u; mine = (j == x) ? c : mine; }
        if (sum == G) break;
        __builtin_amdgcn_s_sleep(1);
        if ((++sp & 255u) == 0u) { if (xb_ld(&bar[XB_TMO])) break; if (sp > XB_SPIN_CAP) { atomicAdd(&bar[XB_TMO], 1u); break; } }
    }
    nloc = mine > 0u ? mine : 1u; nx = cnt > 0u ? cnt : 1u;
}

__device__ __forceinline__ void xcd_barrier(const XcdBarrier& b) {
    asm volatile("s_waitcnt vmcnt(0)" ::: "memory");
    __syncthreads();
    if (threadIdx.x == 0) {
        unsigned* bar = b.bar;
        __builtin_amdgcn_s_waitcnt(0);
        unsigned nloc = b.st[0], nx = b.st[1];
        if (nloc == 0u) { xcd_barrier_complete(bar, b.x, nloc, nx); b.st[0] = nloc; b.st[1] = nx; }
        const unsigned old = xb_add(&bar[XB_XSUB(b.x)], 1u);
        const unsigned gen = old / nloc;
        if (old + 1u == (gen + 1u) * nloc) {
            __builtin_amdgcn_fence(__ATOMIC_RELEASE, "agent");
            asm volatile("s_waitcnt vmcnt(0)" ::: "memory");
            const unsigned og = xb_add(&bar[XB_TOP], 1u);
            const unsigned tg = og / nx;
            if (og + 1u == (tg + 1u) * nx) xb_add(&bar[XB_TOPGEN], 1u);
            else XB_SPIN(xb_ld(&bar[XB_TOPGEN]) == tg, bar);
            __builtin_amdgcn_fence(__ATOMIC_ACQUIRE, "agent");
            xb_add(&bar[XB_XGEN(b.x)], 1u);
            asm volatile("s_waitcnt vmcnt(0)" ::: "memory");
        } else {
            XB_SPIN(xb_ld(&bar[XB_XGEN(b.x)]) == gen, bar);
            __builtin_amdgcn_fence(__ATOMIC_ACQUIRE, "agent");
            asm volatile("s_waitcnt vmcnt(0)" ::: "memory");
        }
    }
    __syncthreads();
}
constexpr int NB = 8, SEQ = 8192, DM = 1024, NPROJ = 3328, M = NB * SEQ, NLAYER = 2;
constexpr int NWAVES = 8;
#ifndef MK_N_LAUNCHES
#define MK_N_LAUNCHES 1
#endif
constexpr int N_LAUNCHES = MK_N_LAUNCHES;
constexpr int N_PHASES = 7;
constexpr int C_AQ = 0, C_AK = 256, C_AV = 512, C_AG = 768, C_BU = 1024, C_BG = 1280, C_CQ = 1536, C_CK = 1792, C_CV = 1920, C_CG = 2048, C_DH = 2304, C_DB = 2560, C_DC = 2816, C_DG = 3072;
constexpr size_t MiB = 1u << 20;
constexpr size_t WS_CTL = 0, CTL_ZERO_BYTES = 2 * MiB;
constexpr size_t WS_KMEAN = 256 * 1024;
constexpr size_t WS_SSQ2 = 1 * MiB;
constexpr size_t WS_SSQ1 = 2 * MiB;
constexpr size_t WS_WIN = 4 * MiB;
constexpr size_t WS_WOUT = 18 * MiB;
constexpr size_t WS_XB = 32 * MiB;
constexpr size_t WS_Y = 160 * MiB;
constexpr size_t WS_PROJ = 288 * MiB;
constexpr size_t WS_END = 704 * MiB;
static_assert(WS_WIN + 2 * (size_t)NPROJ * DM * 2 <= WS_WOUT && WS_WOUT + 2 * (size_t)DM * DM * 2 <= WS_XB && WS_XB + (size_t)M * DM * 2 <= WS_Y && WS_Y + (size_t)M * DM * 2 <= WS_PROJ && WS_PROJ + (size_t)M * NPROJ * 2 <= WS_END, "d_ws map");
constexpr int CW_TMO = 0, CW_BAR = 4096;
static_assert((CW_BAR + XCD_BAR_WORDS) * 4 <= (int)WS_KMEAN && WS_KMEAN + 2 * 65536 * 4 <= WS_SSQ2 && WS_SSQ2 + (size_t)M * 4 <= CTL_ZERO_BYTES, "ctl map");
constexpr int RING_OFF = 0, RING_BYTES = 131072;
constexpr int LDSCTL_OFF = RING_BYTES, MISC_OFF = LDSCTL_OFF + 320;
constexpr int LDS_BYTES = 147456;

struct Frame {
    LAS unsigned char* lds; volatile LAS unsigned* MISC; gu32* ctl;
    int tid, lane, wave, vcu, G;
    const float *x, *norm_g, *w_in, *w_out, *a_qn, *a_kn, *pool_w, *pool_scale, *c_qn, *c_kn, *c_sinks, *conv_w;
    float* out;
    bf16 *Win_t, *Wout_t, *XB, *Y, *PROJ; float *kmean, *ssq1, *ssq2;
    __device__ __forceinline__ void refresh() { int t = threadIdx.x; asm volatile("" : "+v"(t)); tid = t; lane = t & 63; wave = __builtin_amdgcn_readfirstlane(t >> 6); int v = vcu; asm volatile("" : "+s"(v)); vcu = v; }
};
__device__ __forceinline__ float bf2f(bf16 b) { return __uint_as_float((unsigned)b << 16); }
__device__ __forceinline__ float wave_sum(float v) {
#pragma unroll
    for (int o = 1; o < 64; o <<= 1) v += __shfl_xor(v, o);
    return v;
}
__device__ __forceinline__ float wave_max(float v) {
#pragma unroll
    for (int o = 1; o < 64; o <<= 1) v = fmaxf(v, __shfl_xor(v, o));
    return v;
}
__device__ __forceinline__ float rdl(float v, int l) { return __uint_as_float((unsigned)__builtin_amdgcn_readlane((int)__float_as_uint(v), l)); }
__device__ __forceinline__ void p0_store_item(LAS float* scr, bf16* WT, int prow0, int k0, int lane) {
    LDS_WAIT(); asm volatile("" ::: "memory");
    const int c = lane & 7;
#pragma unroll
    for (int j = 0; j < 4; ++j) { const int n = (lane >> 3) + 8 * j; const LAS float* s = scr + (8 * c) * 33 + n;
        v4u o; o.x = pk2(s[0 * 33], s[1 * 33]); o.y = pk2(s[2 * 33], s[3 * 33]); o.z = pk2(s[4 * 33], s[5 * 33]); o.w = pk2(s[6 * 33], s[7 * 33]);
        *(GAS v4u*)(WT + (size_t)(prow0 + n) * 1024 + k0 + 8 * c) = o; }
    LDS_WAIT(); asm volatile("" ::: "memory");
}
__device__ __forceinline__ void p0_prologue(Frame& F) {
    F.refresh();
    LAS float* scr = (LAS float*)(F.lds + RING_OFF + F.wave * 16384);
    const int gw = F.vcu * NWAVES + F.wave, NGW = F.G * NWAVES, lane = F.lane;
    constexpr int I_IN = 16 * 104, I_OUT = 16 * 32, I_L = I_IN + I_OUT;
    for (int it = gw; it < NLAYER * I_L; it += NGW) {
        const int l = it / I_L; int r = it % I_L;
        if (r < I_IN) {
            const int kb = r / 104, nb = r % 104, k0 = 64 * kb, n0 = 32 * nb;
            const float* W = F.w_in + (size_t)l * 1024 * NPROJ; const float* gn = F.norm_g + l * 1024;
            if (n0 >= C_BU && n0 < C_BG) {
                const int g = (n0 - C_BU) >> 6, np = ((n0 - C_BU) & 63) + (lane & 31); const float* pw = F.pool_w + ((size_t)l * 4 + g) * 64 * 64; const float ps = F.pool_scale[l * 256 + (n0 - C_BU) + (lane & 31)];
                for (int i = 0; i < 32; ++i) { const int kk = 2 * i + (lane >> 5); const float* wrow = W + (size_t)(k0 + kk) * NPROJ + C_BU + 64 * g; float s = 0.f;
#pragma unroll 8
                    for (int cc = 0; cc < 64; ++cc) s += wrow[cc] * pw[cc * 64 + np];
                    scr[kk * 33 + (lane & 31)] = s * ps * gn[k0 + kk]; }
            } else {
#pragma unroll 8
                for (int i = 0; i < 32; ++i) { const int kk = 2 * i + (lane >> 5); scr[kk * 33 + (lane & 31)] = W[(size_t)(k0 + kk) * NPROJ + n0 + (lane & 31)] * gn[k0 + kk]; }
            }
            const int pn = n0 >> 8, cc0 = n0 & 255, prow0 = pn * 256 + 128 * ((cc0 >> 5) & 1) + 32 * (cc0 >> 6);
            p0_store_item(scr, F.Win_t + (size_t)l * NPROJ * 1024, prow0, k0, lane);
        } else {
            r -= I_IN; const int kb = r / 32, nb = r % 32, k0 = 64 * kb, n0 = 32 * nb; const float* W = F.w_out + (size_t)l * 1024 * 1024;
#pragma unroll 8
            for (int i = 0; i < 32; ++i) { const int kk = 2 * i + (lane >> 5); scr[kk * 33 + (lane & 31)] = W[(size_t)(k0 + kk) * 1024 + n0 + (lane & 31)]; }
            p0_store_item(scr, F.Wout_t + (size_t)l * 1024 * 1024, n0, k0, lane);
        }
    }
    for (int m = gw; m < M; m += NGW) {
        const GAS f32x4* xr = (const GAS f32x4*)(F.x + (size_t)m * DM) + lane; f32x4 v[4]; float s = 0.f;
#pragma unroll
        for (int j = 0; j < 4; ++j) { v[j] = xr[64 * j]; s += (v[j].x * v[j].x + v[j].y * v[j].y) + (v[j].z * v[j].z + v[j].w * v[j].w); }
        s = wave_sum(s); if (lane == 0) F.ssq1[m] = s;
        GAS unsigned long long* o8 = (GAS unsigned long long*)(F.XB + (size_t)m * DM) + lane;
#pragma unroll
        for (int j = 0; j < 4; ++j) o8[64 * j] = (unsigned long long)pk2(v[j].x, v[j].y) | ((unsigned long long)pk2(v[j].z, v[j].w) << 32);
    }
}
__device__ __forceinline__ float dot64_bf16(float qv, const bf16* p) {
    float s = 0.f;
#pragma unroll
    for (int c = 0; c < 8; ++c) { const v4u w = *(const GAS v4u*)(p + 8 * c); const unsigned ww[4] = {w.x, w.y, w.z, w.w};
#pragma unroll
        for (int i = 0; i < 4; ++i) { s += rdl(qv, 8 * c + 2 * i) * __uint_as_float(ww[i] << 16); s += rdl(qv, 8 * c + 2 * i + 1) * __uint_as_float(ww[i] & 0xffff0000u); } }
    return s;
}
__device__ __forceinline__ void moba_naive(Frame& F, int layer) {
    F.refresh();
    const bf16* P = F.PROJ; const float* kmean = F.kmean + (size_t)layer * 65536; const int lane = F.lane;
    const int gw = F.vcu * NWAVES + F.wave, NGW = F.G * NWAVES;
    for (int it = gw; it < M * 4; it += NGW) {
        const int h = it & 3, row = it >> 2, b = row >> 13, t = row & 8191, own = t >> 8;
        const float sl2 = __builtin_amdgcn_exp2f(-(float)(5 + h)) * 1.4426950408889634f;
        const float qv = bf2f(P[(size_t)row * NPROJ + C_AQ + h * 64 + lane]);
        float bs = -INFINITY;
        { const int n = lane < own ? lane : 0; const float* km = kmean + ((size_t)(b * 4 + h) * 32 + n) * 64; float s = 0.f;
#pragma unroll
          for (int d = 0; d < 64; ++d) s += rdl(qv, d) * km[d];
          if (lane < own) bs = s; }
        int sel[3];
#pragma unroll
        for (int j = 0; j < 3; ++j) { const float mx = wave_max(bs); const unsigned long long bal = __ballot(bs == mx); const int idx = __builtin_amdgcn_readfirstlane(__ffsll((long long)bal) - 1); sel[j] = idx; if (lane == idx) bs = -INFINITY; }
        float sc[16];
#pragma unroll
        for (int s = 0; s < 4; ++s) { const int blk = s < 3 ? sel[s] : own; const bool valid = s < 3 ? (s < own) : true;
#pragma unroll
            for (int c = 0; c < 4; ++c) { float v = -INFINITY;
                if (valid) { const int key = blk * 256 + c * 64 + lane; const float d = dot64_bf16(qv, P + (size_t)(b * SEQ + key) * NPROJ + C_AK + h * 64); v = d + sl2 * (float)(key - t); if (key > t) v = -INFINITY; }
                sc[s * 4 + c] = v; } }
        float mx = sc[0];
#pragma unroll
        for (int i = 1; i < 16; ++i) mx = fmaxf(mx, sc[i]);
        mx = wave_max(mx); float l = 0.f;
#pragma unroll
        for (int i = 0; i < 16; ++i) { sc[i] = __builtin_amdgcn_exp2f(sc[i] - mx); l += sc[i]; }
        l = wave_sum(l); float acc = 0.f;
#pragma unroll
        for (int s = 0; s < 4; ++s) { const int blk = s < 3 ? sel[s] : own; const bool valid = s < 3 ? (s < own) : true;
            if (valid) {
#pragma unroll
                for (int c = 0; c < 4; ++c) { const bf16* vp = P + (size_t)(b * SEQ + blk * 256 + c * 64) * NPROJ + C_AV + h * 64 + lane; const float pc = sc[s * 4 + c];
#pragma unroll 8
                    for (int j = 0; j < 64; ++j) acc += rdl(pc, j) * bf2f(vp[(size_t)j * NPROJ]); } } }
        const float gate = bf2f(P[(size_t)row * NPROJ + C_AG + h * 64 + lane]);
        F.Y[(size_t)row * DM + h * 64 + lane] = (bf16)f2bf(acc / l * gate);
    }
}
__device__ __forceinline__ void swa_naive(Frame& F, int layer) {
    F.refresh();
    const bf16* P = F.PROJ; const int lane = F.lane; const int gw = F.vcu * NWAVES + F.wave, NGW = F.G * NWAVES;
    for (int it = gw; it < M * 4; it += NGW) {
        const int hq = it & 3, kv = hq >> 1, row = it >> 2, b = row >> 13, t = row & 8191;
        const float sl2 = __builtin_amdgcn_exp2f(-(float)(1 + hq)) * 1.4426950408889634f;
        const float qv = bf2f(P[(size_t)row * NPROJ + C_CQ + hq * 64 + lane]);
        float sc[2];
#pragma unroll
        for (int c = 0; c < 2; ++c) { const int key = t - 127 + c * 64 + lane; const int kc = key < 0 ? 0 : key;
            const float d = dot64_bf16(qv, P + (size_t)(b * SEQ + kc) * NPROJ + C_CK + kv * 64); sc[c] = key < 0 ? -INFINITY : d + sl2 * (float)(key - t); }
        const float mx = wave_max(fmaxf(sc[0], sc[1])); float l = 0.f;
#pragma unroll
        for (int c = 0; c < 2; ++c) { sc[c] = __builtin_amdgcn_exp2f(sc[c] - mx); l += sc[c]; }
        l = wave_sum(l) + __builtin_amdgcn_exp2f(F.c_sinks[layer * 4 + hq] * 1.4426950408889634f - mx);
        float acc = 0.f;
#pragma unroll
        for (int c = 0; c < 2; ++c) { const int k0 = t - 127 + c * 64; const float pc = sc[c];
#pragma unroll 8
            for (int j = 0; j < 64; ++j) { const int key = k0 + j; const int kc = key < 0 ? 0 : key; acc += rdl(pc, j) * bf2f(P[(size_t)(b * SEQ + kc) * NPROJ + C_CV + kv * 64 + lane]); } }
        const float gate = bf2f(P[(size_t)row * NPROJ + C_CG + hq * 64 + lane]);
        F.Y[(size_t)row * DM + 512 + hq * 64 + lane] = (bf16)f2bf(acc / l * gate);
    }
}
__device__ __forceinline__ void unpack8(const v4u w, float (&f)[8]) { f[0] = __uint_as_float(w.x << 16); f[1] = __uint_as_float(w.x & 0xffff0000u); f[2] = __uint_as_float(w.y << 16); f[3] = __uint_as_float(w.y & 0xffff0000u);
    f[4] = __uint_as_float(w.z << 16); f[5] = __uint_as_float(w.z & 0xffff0000u); f[6] = __uint_as_float(w.w << 16); f[7] = __uint_as_float(w.w & 0xffff0000u); }
__device__ __forceinline__ void poolconv_naive(Frame& F, int layer) {
    F.refresh();
    const bf16* P = F.PROJ; const long gt = (long)F.vcu * (NWAVES * 64) + F.tid, NGT = (long)F.G * NWAVES * 64;
    for (long it = gt; it < (long)M * 64; it += NGT) {
        const int c8 = (int)(it & 63), row = (int)(it >> 6), t = row & 8191; float o[8];
        if (c8 < 32) {
            const int c = 8 * c8, w = 2 << (c >> 6), cnt = (t + 1) < w ? (t + 1) : w; float s[8] = {0.f, 0.f, 0.f, 0.f, 0.f, 0.f, 0.f, 0.f}, u0[8];
            for (int j = 0; j < cnt; ++j) { float u[8]; unpack8(*(const GAS v4u*)(P + (size_t)(row - j) * NPROJ + C_BU + c), u);
#pragma unroll
                for (int e = 0; e < 8; ++e) { s[e] += u[e]; if (j == 0) u0[e] = u[e]; } }
            float g[8]; unpack8(*(const GAS v4u*)(P + (size_t)row * NPROJ + C_BG + c), g); const float ic = 1.0f / (float)cnt;
#pragma unroll
            for (int e = 0; e < 8; ++e) o[e] = (s[e] * ic - u0[e]) * g[e];
            v4u w4; w4.x = pk2(o[0], o[1]); w4.y = pk2(o[2], o[3]); w4.z = pk2(o[4], o[5]); w4.w = pk2(o[6], o[7]); *(GAS v4u*)(F.Y + (size_t)row * DM + 256 + c) = w4;
        } else {
            const int c = 8 * (c8 - 32); const float* cw = F.conv_w + (size_t)layer * 3 * 256 + c; float s[8] = {0.f, 0.f, 0.f, 0.f, 0.f, 0.f, 0.f, 0.f};
#pragma unroll
            for (int j = 0; j < 3; ++j) { if (t - 2 + j >= 0) { float a[8], hh[8]; const size_t ro = (size_t)(row - 2 + j) * NPROJ; unpack8(*(const GAS v4u*)(P + ro + C_DC + c), a); unpack8(*(const GAS v4u*)(P + ro + C_DH + c), hh);
#pragma unroll
                    for (int e = 0; e < 8; ++e) s[e] += cw[j * 256 + e] * (a[e] * hh[e]); } }
            float bb[8], g[8]; unpack8(*(const GAS v4u*)(P + (size_t)row * NPROJ + C_DB + c), bb); unpack8(*(const GAS v4u*)(P + (size_t)row * NPROJ + C_DG + c), g);
#pragma unroll
            for (int e = 0; e < 8; ++e) o[e] = bb[e] * s[e] * g[e];
            v4u w4; w4.x = pk2(o[0], o[1]); w4.y = pk2(o[2], o[3]); w4.z = pk2(o[4], o[5]); w4.w = pk2(o[6], o[7]); *(GAS v4u*)(F.Y + (size_t)row * DM + 768 + c) = w4;
        }
    }
}
struct Args { const float* in[12]; float* out; unsigned char* ws; int ph_lo, ph_hi, li, pad; };
__global__ void __launch_bounds__(NWAVES * 64, 2) hybrid_fwd(Args args) {
    extern __shared__ __attribute__((aligned(16))) unsigned char lds[];
    Frame F;
    F.lds = (LAS unsigned char*)lds; F.MISC = (volatile LAS unsigned*)(F.lds + MISC_OFF);
    F.tid = threadIdx.x; F.lane = F.tid & 63; F.wave = __builtin_amdgcn_readfirstlane(F.tid >> 6);
    F.G = gridDim.x; { const int bx = blockIdx.x; F.vcu = (F.G % 8 == 0) ? (bx % 8) * (F.G / 8) + bx / 8 : bx; }
    unsigned char* ws = args.ws;
    F.ctl = (gu32*)(ws + WS_CTL);
    F.x = args.in[0]; F.norm_g = args.in[1]; F.w_in = args.in[2]; F.w_out = args.in[3]; F.a_qn = args.in[4]; F.a_kn = args.in[5]; F.pool_w = args.in[6]; F.pool_scale = args.in[7];
    F.c_qn = args.in[8]; F.c_kn = args.in[9]; F.c_sinks = args.in[10]; F.conv_w = args.in[11]; F.out = args.out;
    F.Win_t = (bf16*)(ws + WS_WIN); F.Wout_t = (bf16*)(ws + WS_WOUT); F.XB = (bf16*)(ws + WS_XB); F.Y = (bf16*)(ws + WS_Y); F.PROJ = (bf16*)(ws + WS_PROJ);
    F.kmean = (float*)(ws + WS_KMEAN); F.ssq1 = (float*)(ws + WS_SSQ1); F.ssq2 = (float*)(ws + WS_SSQ2);
    for (int u = F.tid; u < (LDS_BYTES - LDSCTL_OFF) / 4; u += NWAVES * 64) ((LAS unsigned*)(F.lds + LDSCTL_OFF))[u] = 0u;
    __syncthreads();
    XcdBarrier bar; bar.bar = (unsigned*)(F.ctl + CW_BAR); bar.x = 0; bar.st = nullptr;
    if (N_LAUNCHES == 1) bar = xcd_barrier_post((unsigned*)(F.ctl + CW_BAR), F.MISC + 8);
    const int lo = args.ph_lo, hi = args.ph_hi;
#define IN(k) (lo <= (k) && (k) < hi)
#define SEAM(k) do { if (IN(k) && IN((k) + 1)) xcd_barrier(bar); } while (0)
    if (IN(0)) { p0_prologue(F); } SEAM(0);
    for (int l = 0; l < NLAYER; ++l) {
        if (IN(1 + 3 * l)) {
            pg8::Gemm g{F.XB, F.Win_t + (size_t)l * NPROJ * 1024, M, NPROJ, DM}; pg8::StaticOrder S; S.init(M, NPROJ, F.G, (int)blockIdx.x);
            pg8::EpiInProj E{F.PROJ, l == 0 ? F.ssq1 : F.ssq2, F.a_qn + l * 64, F.a_kn + l * 64, F.c_qn + l * 64, F.c_kn + l * 64, F.kmean + (size_t)l * 65536};
            pg8::gemm_phase<pg8::EpiInProj, pg8::StaticOrder, true, true>(F.lds + RING_OFF, g, S, E);
        }
        SEAM(1 + 3 * l);
        if (IN(2 + 3 * l)) { moba_naive(F, l); swa_naive(F, l); poolconv_naive(F, l); }
        SEAM(2 + 3 * l);
        if (IN(3 + 3 * l)) {
            pg8::Gemm g{F.Y, F.Wout_t + (size_t)l * 1024 * 1024, M, DM, DM}; pg8::StaticOrder S; S.init(M, DM, F.G, (int)blockIdx.x);
            pg8::EpiOutProj E{l == 0 ? F.x : F.out, F.out, l == 0 ? F.XB : nullptr, F.ssq2};
            pg8::gemm_phase<pg8::EpiOutProj, pg8::StaticOrder, true, true>(F.lds + RING_OFF, g, S, E);
        }
        if (l + 1 < NLAYER) SEAM(3 + 3 * l);
    }
#undef IN
#undef SEAM
}
extern "C" void kernel_launch(void* const* d_in, const int* in_sizes, int n_in, void* d_out, int out_size, void* d_ws, size_t ws_size, hipStream_t stream) {
    static int grid = 0;
    if (grid == 0) {
        if (n_in != 12 || in_sizes[0] != M * DM || out_size != M * DM || ws_size < WS_END) { fprintf(stderr, "kernel_launch: unexpected shapes (n_in %d, in0 %d, out %d, ws %zu); nothing launched\n", n_in, n_in > 0 ? in_sizes[0] : -1, out_size, ws_size); grid = -1; return; }
        int dev = 0, cus = 0;
        if (hipGetDevice(&dev) != hipSuccess || hipDeviceGetAttribute(&cus, hipDeviceAttributeMultiprocessorCount, dev) != hipSuccess) { grid = -1; return; }
        if (hipFuncSetAttribute((const void*)hybrid_fwd, hipFuncAttributeMaxDynamicSharedMemorySize, LDS_BYTES) != hipSuccess) { fprintf(stderr, "kernel_launch: hipFuncSetAttribute failed\n"); grid = -1; return; }
        (void)hipGetLastError();
        grid = cus;
    }
    if (grid < 0) return;
    if (hipMemsetAsync((char*)d_ws + WS_CTL, 0, CTL_ZERO_BYTES, stream) != hipSuccess) return;
    Args a{};
    for (int i = 0; i < 12; ++i) a.in[i] = (const float*)d_in[i];
    a.out = (float*)d_out; a.ws = (unsigned char*)d_ws;
    for (int li = 0; li < N_LAUNCHES; ++li) {
        a.ph_lo = (N_LAUNCHES == 1) ? 0 : li; a.ph_hi = (N_LAUNCHES == 1) ? N_PHASES : li + 1; a.li = li;
        hipLaunchKernelGGL(hybrid_fwd, dim3(grid), dim3(NWAVES * 64), LDS_BYTES, stream, a);
    }
}
```

```cpp
#include <hip/hip_runtime.h>
#include <cstdio>
#include <cstdint>
#include <cmath>
constexpr int NB = 8, SEQ = 8192, DM = 1024, NPROJ = 3328, M = NB * SEQ, NLAYER = 2;
constexpr int C_AQ = 0, C_AK = 256, C_AV = 512, C_AG = 768, C_BU = 1024, C_BG = 1280, C_CQ = 1536, C_CK = 1792, C_CV = 1920, C_CG = 2048, C_DH = 2304, C_DB = 2560, C_DC = 2816, C_DG = 3072;
#ifndef PROBE_DUP
#define PROBE_DUP 0
#endif

constexpr size_t OFF_QA = 0, OFF_KA = 16ull << 20, OFF_VA = 32ull << 20, OFF_GA = 48ull << 20, OFF_QC = 64ull << 20, OFF_KC = 80ull << 20, OFF_VC = 88ull << 20, OFF_GC = 96ull << 20;
__host__ __device__ __forceinline__ int phys_row(int c) {
    if (c >= C_DH) { const int op = (c - C_DH) >> 8, ch = (c - C_DH) & 255, j = ch >> 6, wc = (ch >> 4) & 3, fq = (ch >> 2) & 3, e = ch & 3; return (9 + j) * 256 + 128 * (op >> 1) + 32 * wc + 8 * fq + 4 * (op & 1) + e; }
    if (c >= C_BU && c < C_CQ) { const int gate = c >= C_BG, ch = c - (gate ? C_BG : C_BU); return (7 + (ch >> 7)) * 256 + 128 * gate + (ch & 127); }
    const int lt = c >> 8, t = lt < 4 ? lt : lt - 2, cc = c & 255; return t * 256 + 128 * ((cc >> 5) & 1) + 32 * (cc >> 6) + (cc & 31);
}

constexpr size_t MiB = 1u << 20;
constexpr size_t WS_CTL = 0, CTL_ZERO_BYTES = 2 * MiB;
constexpr size_t WS_KMEAN = 256 * 1024;
constexpr size_t WS_SSQ2 = 1 * MiB;
constexpr size_t WS_SSQ1 = 2 * MiB;
constexpr size_t WS_WIN = 4 * MiB;
constexpr size_t WS_WOUT = 18 * MiB;
constexpr size_t WS_XB = 32 * MiB;
constexpr size_t WS_Y = 160 * MiB;
constexpr size_t WS_PROJ = 288 * MiB;
constexpr size_t WS_LST = 704 * MiB;
constexpr size_t WS_CNT = 1280 * 1024;
constexpr size_t WS_PARTL = 721 * MiB;
constexpr size_t WS_HALO = 726 * MiB;
constexpr size_t WS_PHALO = 727 * MiB;
constexpr size_t WS_PARTO = 736 * MiB;
constexpr size_t WS_END = 864 * MiB;
namespace pg8 {
#define PG8_LAS __attribute__((address_space(3)))
typedef unsigned short bf16_t;
typedef short bf16x8 __attribute__((ext_vector_type(8)));
typedef float f32x4 __attribute__((ext_vector_type(4)));
typedef unsigned u32x4 __attribute__((ext_vector_type(4)));
constexpr int BM = 256, BK = 64, HALF = 128, HTB = HALF * BK * 2  , STAGE_BYTES = 8 * HTB, NXCD = 8, WGM = 8;

__host__ __device__ __forceinline__ int lds_byte(int r, int c) { const int st = (r >> 4) * 2 + (c >> 5), rr = r & 15, cc = c & 31, ob = rr * 64 + cc * 2; return st * 1024 + (ob ^ (((ob >> 9) & 1) << 5)); }
__host__ __device__ __forceinline__ void stage_rc(int b, int& R, int& C) { const int st = b / 1024, sb = b % 1024, swz = sb ^ (((sb >> 9) & 1) << 5); R = (st >> 1) * 16 + swz / 64; C = (st & 1) * 32 + (swz % 64) / 2; }
__host__ __device__ __forceinline__ int perm32(int rho) { const int n = rho >> 4, i = rho & 15; return 8 * (i >> 2) + 4 * n + (i & 3); }

struct Unit { int pm, pn; };
struct Gemm { const bf16_t* A; const bf16_t* Bt; int M, N, K; };

struct StaticOrder {
    int nM, nN, nwg, G, c;
    __host__ __device__ void init(int M, int N, int G_, int c_) { nM = M / BM; nN = N / BM; nwg = nM * nN; G = G_; c = c_; }
    __host__ __device__ bool next(int i, Unit& u) const {
        const long L = (long)i * G + c; if (L >= nwg) return false;
        int wgid = (int)L; { const int q = nwg / NXCD, r = nwg % NXCD, xcd = wgid % NXCD, off = wgid / NXCD; wgid = (xcd < r ? xcd * (q + 1) : r * (q + 1) + (xcd - r) * q) + off; }
        const int nig = WGM * nN, gid = wgid / nig, fm = gid * WGM, gsz = (nM - fm) < WGM ? (nM - fm) : WGM;
        u.pm = fm + ((wgid % nig) % gsz); u.pn = (wgid % nig) / gsz; return true;
    }
    __device__ __forceinline__ void a_ready(const Unit&) const {}
    __device__ __forceinline__ void done(const Unit&) const {}
};

typedef float pg8_f32x2 __attribute__((ext_vector_type(2))); typedef __bf16 pg8_bf16x2 __attribute__((ext_vector_type(2)));
__device__ __forceinline__ unsigned cvt_pk_bf16(float lo, float hi) { pg8_f32x2 v = {lo, hi}; pg8_bf16x2 b = __builtin_convertvector(v, pg8_bf16x2); return __builtin_bit_cast(unsigned, b); }
typedef float f32x2 __attribute__((ext_vector_type(2)));
#define PG8_GAS __attribute__((address_space(1)))
constexpr float QK_C2 = 0.125f * 1.4426950408889634f;
struct EpiInProj {
    static constexpr bool PERM = true, AFTER_DRAIN = false;
    bf16_t* P; int layer; int do_km;
    __device__ __forceinline__ char* wsb() const { return (char*)P - WS_PROJ; }
    __device__ __forceinline__ void prefetch(PG8_LAS unsigned char* aux, const Unit& u, int ui, int wid, int lane) const {
        const float* ssq = (const float*)(wsb() + (layer == 0 ? WS_SSQ1 : WS_SSQ2));
        if (wid == 0) __builtin_amdgcn_global_load_lds((const unsigned*)(ssq + (size_t)u.pm * BM + lane * 4), (PG8_LAS unsigned*)(aux + (ui & 1) * 1024), 16, 0, 0);
    }
    __device__ __forceinline__ void operator()(const f32x4 (&acc)[2][2][4][2], const Unit& u, int wr, int wc, int fr_in, int fq_in, PG8_LAS unsigned char* aux, int ui) const {
        int fr = fr_in, fq = fq_in; asm volatile("" : "+v"(fr), "+v"(fq));
        const int pn = u.pn;
        const PG8_LAS float* rv = (const PG8_LAS float*)(aux + (ui & 1) * 1024); const PG8_LAS float* gl = (const PG8_LAS float*)(aux + 2048);
        int g = -1; float post = 1.f; bool silu = false, km = false;
        const int lt = pn < 4 ? pn : pn + 2;
        if (lt == 0) { g = 0; post = QK_C2; } else if (lt == 1) { g = 64; km = (do_km != 0); } else if (lt == 6) { g = 128; post = QK_C2; }
        else if (lt == 7) { if (wc < 2) g = 192; } else if (lt == 3 || lt == 8) silu = true;
        float scl[2][4];
#pragma unroll
        for (int ai = 0; ai < 2; ++ai)
#pragma unroll
            for (int m = 0; m < 4; ++m) {
                float sr = __builtin_amdgcn_rsqf(rv[ai * HALF + wr * 64 + m * 16 + fr] * (1.0f / 1024.0f) + 1e-6f);
                if (g >= 0) { float ss = 0.f;
#pragma unroll
                    for (int bj = 0; bj < 2; ++bj)
#pragma unroll
                        for (int n = 0; n < 2; ++n) { const f32x4 q = acc[ai][bj][m][n] * acc[ai][bj][m][n]; ss += (q[0] + q[1]) + (q[2] + q[3]); }
                    ss += __shfl_xor(ss, 16); ss += __shfl_xor(ss, 32);
                    sr = sr * post * __builtin_amdgcn_rsqf(ss * sr * sr * (1.0f / 64.0f) + 1e-6f); }
                scl[ai][m] = sr; }
        const int bb = u.pm >> 5;
        size_t hbase;
        if (lt == 0) hbase = OFF_QA + (size_t)(bb * 4 + wc) * SEQ * 64; else if (lt == 1) hbase = OFF_KA + (size_t)(bb * 4 + wc) * SEQ * 64; else if (lt == 2) hbase = OFF_VA + (size_t)(bb * 4 + wc) * SEQ * 64;
        else if (lt == 3) hbase = OFF_GA + (size_t)(bb * 4 + wc) * SEQ * 64; else if (lt == 6) hbase = OFF_QC + (size_t)(bb * 4 + wc) * SEQ * 64;
        else if (lt == 7) hbase = (wc < 2 ? OFF_KC + (size_t)(bb * 2 + wc) * SEQ * 64 : OFF_VC + (size_t)(bb * 2 + wc - 2) * SEQ * 64); else hbase = OFF_GC + (size_t)(bb * 4 + wc) * SEQ * 64;
        const int lcol = 8 * fq + ((fr >> 3) << 5); const bool lo8 = fr < 8;
        f32x4 cs[2][2], gq[2][2];
#pragma unroll
        for (int bj = 0; bj < 2; ++bj) { cs[bj][0] = (f32x4){0.f, 0.f, 0.f, 0.f}; cs[bj][1] = cs[bj][0]; gq[bj][0] = (f32x4){1.f, 1.f, 1.f, 1.f}; gq[bj][1] = gq[bj][0];
            if (g >= 0) { gq[bj][0] = *(const PG8_LAS f32x4*)(gl + g + 32 * bj + 8 * fq); gq[bj][1] = *(const PG8_LAS f32x4*)(gl + g + 32 * bj + 8 * fq + 4); } }
#pragma unroll
        for (int ai = 0; ai < 2; ++ai)
#pragma unroll
            for (int m = 0; m < 4; ++m) {
                u32x4 w[2];
#pragma unroll
                for (int bj = 0; bj < 2; ++bj) {
                    f32x4 v0 = acc[ai][bj][m][0] * scl[ai][m] * gq[bj][0], v1 = acc[ai][bj][m][1] * scl[ai][m] * gq[bj][1];
                    if (silu) {
#pragma unroll
                        for (int e = 0; e < 4; ++e) { v0[e] = v0[e] * __builtin_amdgcn_rcpf(1.0f + __builtin_amdgcn_exp2f(-1.4426950408889634f * v0[e])); v1[e] = v1[e] * __builtin_amdgcn_rcpf(1.0f + __builtin_amdgcn_exp2f(-1.4426950408889634f * v1[e])); } }
                    if (km) { cs[bj][0] += v0; cs[bj][1] += v1; }
                    w[bj].x = cvt_pk_bf16(v0[0], v0[1]); w[bj].y = cvt_pk_bf16(v0[2], v0[3]); w[bj].z = cvt_pk_bf16(v1[0], v1[1]); w[bj].w = cvt_pk_bf16(v1[2], v1[3]); }
                u32x4 st1, st2;
#pragma unroll
                for (int e = 0; e < 4; ++e) { const unsigned give = lo8 ? w[1][e] : w[0][e]; const unsigned recv = (unsigned)__builtin_amdgcn_mov_dpp((int)give, 0x128, 0xf, 0xf, false);
                    st1[e] = lo8 ? w[0][e] : recv; st2[e] = lo8 ? recv : w[1][e]; }
                const size_t t0 = (size_t)((u.pm & 31) * BM + ai * HALF + wr * 64 + m * 16 + (fr & 7));
                __builtin_nontemporal_store(st1, (PG8_GAS u32x4*)(P + hbase + t0 * 64 + lcol)); __builtin_nontemporal_store(st2, (PG8_GAS u32x4*)(P + hbase + (t0 + 8) * 64 + lcol)); }
        if (km) {
#pragma unroll
            for (int bj = 0; bj < 2; ++bj) {
                float* kmp = (float*)(wsb() + WS_KMEAN) + (size_t)layer * 65536 + ((size_t)((u.pm >> 5) * 4 + wc) * 32 + (u.pm & 31)) * 64 + 32 * bj + 8 * fq;
#pragma unroll
                for (int e = 0; e < 8; ++e) { float s = e < 4 ? cs[bj][0][e & 3] : cs[bj][1][e & 3]; s += __shfl_xor(s, 1); s += __shfl_xor(s, 2); s += __shfl_xor(s, 4); s += __shfl_xor(s, 8);
                    if (fr == 0) __hip_atomic_fetch_add((PG8_GAS float*)(kmp + e), s * (1.0f / 256.0f), __ATOMIC_RELAXED, __HIP_MEMORY_SCOPE_AGENT); } } }
    }
};

struct EpiConv {
    static constexpr bool PERM = true, AFTER_DRAIN = false;
    bf16_t* P; int layer;
    __device__ __forceinline__ char* wsb() const { return (char*)P - WS_PROJ; }
    __device__ __forceinline__ void prefetch(PG8_LAS unsigned char* aux, const Unit& u, int ui, int wid, int lane) const {
        const float* ssq = (const float*)(wsb() + (layer == 0 ? WS_SSQ1 : WS_SSQ2));
        if (wid == 0) __builtin_amdgcn_global_load_lds((const unsigned*)(ssq + (size_t)u.pm * BM + lane * 4), (PG8_LAS unsigned*)(aux + (ui & 1) * 1024), 16, 0, 0);
    }
    __device__ __forceinline__ void operator()(const f32x4 (&acc)[2][2][4][2], const Unit& u, int wr, int wc, int fr_in, int fq_in, PG8_LAS unsigned char* aux, int ui) const {
        int fr = fr_in, fq = fq_in; asm volatile("" : "+v"(fr), "+v"(fq));
        const PG8_LAS float* rv = (const PG8_LAS float*)(aux + (ui & 1) * 1024);
        float scl[2][4];
#pragma unroll
        for (int ai = 0; ai < 2; ++ai)
#pragma unroll
            for (int m = 0; m < 4; ++m) scl[ai][m] = __builtin_amdgcn_rsqf(rv[ai * HALF + wr * 64 + m * 16 + fr] * (1.0f / 1024.0f) + 1e-6f);
        {
            const int j = u.pn, chg = 64 * j + 16 * wc + 4 * fq;
            bf16_t* Y = (bf16_t*)(wsb() + WS_Y); float* Hu = (float*)(wsb() + WS_HALO); float* Hg = Hu + 256 * 2 * 256;
            const PG8_LAS float* cw = (const PG8_LAS float*)(aux + 4096); PG8_LAS float* hx = (PG8_LAS float*)(aux + 8192);
            const f32x4 w0 = *(const PG8_LAS f32x4*)(cw + chg), w1 = *(const PG8_LAS f32x4*)(cw + 256 + chg), w2 = *(const PG8_LAS f32x4*)(cw + 512 + chg);
            if (fr >= 14) {
#pragma unroll
                for (int ai = 0; ai < 2; ++ai) { const float sc = scl[ai][3]; *(PG8_LAS f32x4*)(hx + (((2 * ai + wr) * 4 + wc) * 2 + (fr - 14)) * 16 + 4 * fq) = (acc[ai][1][3][0] * sc) * (acc[ai][0][3][0] * sc); } }
            asm volatile("s_waitcnt lgkmcnt(0)" ::: "memory"); __builtin_amdgcn_s_barrier(); asm volatile("" ::: "memory");
#pragma unroll
            for (int ai = 0; ai < 2; ++ai) {
                const int seg = 2 * ai + wr; f32x4 h1 = (f32x4){0.f, 0.f, 0.f, 0.f}, h2 = h1;
                if (seg > 0) { h2 = *(const PG8_LAS f32x4*)(hx + (((seg - 1) * 4 + wc) * 2 + 0) * 16 + 4 * fq); h1 = *(const PG8_LAS f32x4*)(hx + (((seg - 1) * 4 + wc) * 2 + 1) * 16 + 4 * fq); }
                f32x4 prv = (f32x4){0.f, 0.f, 0.f, 0.f};
#pragma unroll
                for (int m = 0; m < 4; ++m) {
                    const float sc = scl[ai][m]; const f32x4 cur = (acc[ai][1][m][0] * sc) * (acc[ai][0][m][0] * sc); f32x4 u1, u2;
#pragma unroll
                    for (int e2 = 0; e2 < 4; ++e2) {
                        const float c1 = __int_as_float(__builtin_amdgcn_update_dpp(0, __float_as_int(cur[e2]), 0x121, 0xf, 0xf, false)), c2 = __int_as_float(__builtin_amdgcn_update_dpp(0, __float_as_int(cur[e2]), 0x122, 0xf, 0xf, false));
                        float p1, p2;
                        if (m > 0) { const float pv_ = prv[e2]; p1 = __int_as_float(__builtin_amdgcn_update_dpp(0, __float_as_int(pv_), 0x121, 0xf, 0xf, false)); p2 = __int_as_float(__builtin_amdgcn_update_dpp(0, __float_as_int(pv_), 0x122, 0xf, 0xf, false)); }
                        else { p1 = h1[e2]; p2 = (fr == 1) ? h1[e2] : h2[e2]; }
                        u1[e2] = fr >= 1 ? c1 : p1; u2[e2] = fr >= 2 ? c2 : p2; }
                    const f32x4 dbv = acc[ai][0][m][1] * sc, dgv = acc[ai][1][m][1] * sc; f32x4 gg;
#pragma unroll
                    for (int e2 = 0; e2 < 4; ++e2) gg[e2] = dbv[e2] * dgv[e2] * __builtin_amdgcn_rcpf(1.0f + __builtin_amdgcn_exp2f(-1.4426950408889634f * dgv[e2]));
                    const f32x4 o = gg * (w0 * u2 + w1 * u1 + w2 * cur);
                    const size_t r = (size_t)(u.pm * BM + ai * HALF + wr * 64 + m * 16 + fr);
                    typedef unsigned u32x2 __attribute__((ext_vector_type(2)));
                    u32x2 w; w.x = cvt_pk_bf16(o[0], o[1]); w.y = cvt_pk_bf16(o[2], o[3]); *(PG8_GAS u32x2*)(Y + r * 1024 + 768 + chg) = w;
                    if (seg == 3 && m == 3 && fr >= 14) *(PG8_GAS f32x4*)(Hu + ((size_t)u.pm * 2 + (fr - 14)) * 256 + chg) = cur;
                    if (seg == 0 && m == 0 && fr < 2) *(PG8_GAS f32x4*)(Hg + ((size_t)u.pm * 2 + fr) * 256 + chg) = gg;
                    prv = cur;
                    __builtin_amdgcn_sched_barrier(0);
                }
            }
        }
    }
};

template <int K> __device__ __forceinline__ float row_shift(float cur, float prev, int fr) {
    const float a = __int_as_float(__builtin_amdgcn_update_dpp(0, __float_as_int(cur), 0x120 + K, 0xf, 0xf, false)), b = __int_as_float(__builtin_amdgcn_update_dpp(0, __float_as_int(prev), 0x120 + K, 0xf, 0xf, false));
    return fr >= K ? a : b;
}
struct EpiPool {
    static constexpr bool PERM = true, AFTER_DRAIN = false;
    bf16_t* P; int layer;
    __device__ __forceinline__ char* wsb() const { return (char*)P - WS_PROJ; }
    __device__ __forceinline__ void prefetch(PG8_LAS unsigned char* aux, const Unit& u, int ui, int wid, int lane) const {
        const float* ssq = (const float*)(wsb() + (layer == 0 ? WS_SSQ1 : WS_SSQ2));
        if (wid == 0) __builtin_amdgcn_global_load_lds((const unsigned*)(ssq + (size_t)u.pm * BM + lane * 4), (PG8_LAS unsigned*)(aux + (ui & 1) * 1024), 16, 0, 0);
    }
    __device__ __forceinline__ void operator()(const f32x4 (&acc)[2][2][4][2], const Unit& u, int wr, int wc, int fr_in, int fq_in, PG8_LAS unsigned char* aux, int ui) const {
        int fr = fr_in, fq = fq_in; asm volatile("" : "+v"(fr), "+v"(fq));
        const PG8_LAS float* rv = (const PG8_LAS float*)(aux + (ui & 1) * 1024);
        float scl[2][4];
#pragma unroll
        for (int ai = 0; ai < 2; ++ai)
#pragma unroll
            for (int m = 0; m < 4; ++m) scl[ai][m] = __builtin_amdgcn_rsqf(rv[ai * HALF + wr * 64 + m * 16 + fr] * (1.0f / 1024.0f) + 1e-6f);
        const int j = u.pn, grp = 2 * j + (wc >> 1), w = 2 << grp, chg = 128 * j + 32 * wc + 8 * fq;
        bf16_t* Y = (bf16_t*)(wsb() + WS_Y); float* Hpu = (float*)(wsb() + WS_PHALO); float* Hpg = Hpu + 256 * 16 * 256;
        PG8_LAS unsigned char* hx = aux + 8192;
#pragma unroll
        for (int ai = 0; ai < 2; ++ai) { const float sc = scl[ai][3]; const f32x4 v0 = acc[ai][0][3][0] * sc, v1 = acc[ai][0][3][1] * sc;
            u32x4 q; q.x = cvt_pk_bf16(v0[0], v0[1]); q.y = cvt_pk_bf16(v0[2], v0[3]); q.z = cvt_pk_bf16(v1[0], v1[1]); q.w = cvt_pk_bf16(v1[2], v1[3]);
            *(PG8_LAS u32x4*)(hx + ((2 * ai + wr) * 4 + wc) * 1024 + fr * 64 + fq * 16) = q; }
        asm volatile("s_waitcnt lgkmcnt(0)" ::: "memory"); __builtin_amdgcn_s_barrier(); asm volatile("" ::: "memory");
        const bool seqstart = (u.pm & 31) == 0;
#pragma unroll
        for (int ai = 0; ai < 2; ++ai) {
            const int seg = 2 * ai + wr; float hal[8];
            if (seg > 0) { const u32x4 q = *(const PG8_LAS u32x4*)(hx + ((seg - 1) * 4 + wc) * 1024 + fr * 64 + fq * 16);
                hal[0] = __uint_as_float(q.x << 16); hal[1] = __uint_as_float(q.x & 0xffff0000u); hal[2] = __uint_as_float(q.y << 16); hal[3] = __uint_as_float(q.y & 0xffff0000u);
                hal[4] = __uint_as_float(q.z << 16); hal[5] = __uint_as_float(q.z & 0xffff0000u); hal[6] = __uint_as_float(q.w << 16); hal[7] = __uint_as_float(q.w & 0xffff0000u); }
            else {
#pragma unroll
                for (int c8 = 0; c8 < 8; ++c8) hal[c8] = 0.f; }
            float S[4][8];
#pragma unroll
            for (int c8 = 0; c8 < 8; ++c8) {
                float x0 = hal[c8], x1 = acc[ai][0][0][c8 >> 2][c8 & 3] * scl[ai][0], x2 = acc[ai][0][1][c8 >> 2][c8 & 3] * scl[ai][1], x3 = acc[ai][0][2][c8 >> 2][c8 & 3] * scl[ai][2], x4 = acc[ai][0][3][c8 >> 2][c8 & 3] * scl[ai][3];
#define POOL_STEP(K) if (K < w) { x4 += row_shift<K>(x4, x3, fr); x3 += row_shift<K>(x3, x2, fr); x2 += row_shift<K>(x2, x1, fr); x1 += row_shift<K>(x1, x0, fr); x0 += row_shift<K>(x0, 0.f, fr); }
                POOL_STEP(1) POOL_STEP(2) POOL_STEP(4) POOL_STEP(8)
#undef POOL_STEP
                S[0][c8] = x1; S[1][c8] = x2; S[2][c8] = x3; S[3][c8] = x4; }
#pragma unroll
            for (int m = 0; m < 4; ++m) {
                const float sc = scl[ai][m]; const int t = 16 * m + fr;
                const float ic = (seqstart && seg == 0 && t < w - 1) ? __builtin_amdgcn_rcpf((float)(t + 1)) : __builtin_amdgcn_rcpf((float)w);
                float o[8], uu[8], gg[8];
#pragma unroll
                for (int c8 = 0; c8 < 8; ++c8) { uu[c8] = acc[ai][0][m][c8 >> 2][c8 & 3] * sc; const float gv = acc[ai][1][m][c8 >> 2][c8 & 3] * sc;
                    gg[c8] = gv * __builtin_amdgcn_rcpf(1.0f + __builtin_amdgcn_exp2f(-1.4426950408889634f * gv)); o[c8] = (S[m][c8] * ic - uu[c8]) * gg[c8]; }
                const size_t r = (size_t)(u.pm * BM + ai * HALF + wr * 64 + m * 16 + fr);
                u32x4 q; q.x = cvt_pk_bf16(o[0], o[1]); q.y = cvt_pk_bf16(o[2], o[3]); q.z = cvt_pk_bf16(o[4], o[5]); q.w = cvt_pk_bf16(o[6], o[7]);
                *(PG8_GAS u32x4*)(Y + r * 1024 + 256 + chg) = q;
                if (seg == 3 && m == 3) { float* hp = Hpu + ((size_t)u.pm * 16 + fr) * 256 + chg; *(PG8_GAS f32x4*)hp = (f32x4){uu[0], uu[1], uu[2], uu[3]}; *(PG8_GAS f32x4*)(hp + 4) = (f32x4){uu[4], uu[5], uu[6], uu[7]}; }
                if (seg == 0 && m == 0) { float* hp = Hpg + ((size_t)u.pm * 16 + fr) * 256 + chg; *(PG8_GAS f32x4*)hp = (f32x4){gg[0], gg[1], gg[2], gg[3]}; *(PG8_GAS f32x4*)(hp + 4) = (f32x4){gg[4], gg[5], gg[6], gg[7]}; }
                __builtin_amdgcn_sched_barrier(0);
            }
        }
    }
};

struct EpiPoolConv {
    static constexpr bool PERM = true, AFTER_DRAIN = false;
    bf16_t* P; int layer;
    __device__ __forceinline__ void prefetch(PG8_LAS unsigned char* aux, const Unit& u, int ui, int wid, int lane) const { EpiPool E{P, layer}; E.prefetch(aux, u, ui, wid, lane); }
    __device__ __forceinline__ void operator()(const f32x4 (&acc)[2][2][4][2], const Unit& u, int wr, int wc, int fr, int fq, PG8_LAS unsigned char* aux, int ui) const {
        if (u.pn < 2) { EpiPool E{P, layer}; E(acc, u, wr, wc, fr, fq, aux, ui); }
        else { EpiConv E{P, layer}; Unit v = u; v.pn = u.pn - 2; E(acc, v, wr, wc, fr, fq, aux, ui); }
    }
};

struct EpiInAll {
    static constexpr bool PERM = true, AFTER_DRAIN = false;
    bf16_t* P; int layer; int do_km;
    __device__ __forceinline__ void prefetch(PG8_LAS unsigned char* aux, const Unit& u, int ui, int wid, int lane) const { EpiPool E{P, layer}; E.prefetch(aux, u, ui, wid, lane); }
    __device__ __forceinline__ void operator()(const f32x4 (&acc)[2][2][4][2], const Unit& u, int wr, int wc, int fr, int fq, PG8_LAS unsigned char* aux, int ui) const {
        if (u.pn < 7) { EpiInProj E{P, layer, do_km}; E(acc, u, wr, wc, fr, fq, aux, ui); }
        else if (u.pn < 9) { EpiPool E{P, layer}; Unit v = u; v.pn = u.pn - 7; E(acc, v, wr, wc, fr, fq, aux, ui); }
        else { EpiConv E{P, layer}; Unit v = u; v.pn = u.pn - 9; E(acc, v, wr, wc, fr, fq, aux, ui); }
    }
};
struct EpiOutProj {
    static constexpr bool PERM = true, AFTER_DRAIN = false;
    const bf16_t* xin_b; float* xout; bf16_t* xb; float* ssq;
    __device__ __forceinline__ void prefetch(PG8_LAS unsigned char*, const Unit&, int, int, int) const {}
    __device__ __forceinline__ f32x4 xch(const f32x4 give) const { f32x4 r;
#pragma unroll
        for (int e = 0; e < 4; ++e) r[e] = __int_as_float(__builtin_amdgcn_update_dpp(0, __float_as_int(give[e]), 0x128, 0xf, 0xf, false));
        return r; }
    __device__ __forceinline__ void operator()(const f32x4 (&acc)[2][2][4][2], const Unit& u, int wr, int wc, int fr_in, int fq_in, PG8_LAS unsigned char*, int) const {
        int fr = fr_in, fq = fq_in; asm volatile("" : "+v"(fr), "+v"(fq));
        const int col0 = u.pn * BM + wc * 32 + 8 * fq; const bool lo8 = fr < 8; const int cpart = lo8 ? 0 : 4;
        u32x4 rb[2][4][2];
#pragma unroll
        for (int ai = 0; ai < 2; ++ai)
#pragma unroll
            for (int m = 0; m < 4; ++m)
#pragma unroll
                for (int bj = 0; bj < 2; ++bj) rb[ai][m][bj] = __builtin_nontemporal_load((const PG8_GAS u32x4*)(xin_b + (size_t)(u.pm * BM + ai * HALF + wr * 64 + m * 16 + fr) * 1024 + col0 + bj * HALF));
#pragma unroll
        for (int ai = 0; ai < 2; ++ai)
#pragma unroll
            for (int m = 0; m < 4; ++m) {
                const int rg = u.pm * BM + ai * HALF + wr * 64 + m * 16; const int r = rg + fr; const size_t off = (size_t)r * 1024 + col0; float ss = 0.f;
                const size_t offA = (size_t)(rg + (fr & 7)) * 1024 + col0 + cpart, offB = offA + 8 * 1024;
#pragma unroll
                for (int bj = 0; bj < 2; ++bj) { const u32x4 q = rb[ai][m][bj];
                    const f32x4 r0 = (f32x4){__uint_as_float(q.x << 16), __uint_as_float(q.x & 0xffff0000u), __uint_as_float(q.y << 16), __uint_as_float(q.y & 0xffff0000u)};
                    const f32x4 r1 = (f32x4){__uint_as_float(q.z << 16), __uint_as_float(q.z & 0xffff0000u), __uint_as_float(q.w << 16), __uint_as_float(q.w & 0xffff0000u)};
                    const f32x4 v0 = acc[ai][bj][m][0] + r0, v1 = acc[ai][bj][m][1] + r1;
                    if (xout) { const f32x4 rc = xch(lo8 ? v1 : v0); const f32x4 s1 = lo8 ? v0 : rc, s2 = lo8 ? rc : v1;
                        __builtin_nontemporal_store(s1, (PG8_GAS f32x4*)(xout + offA + bj * HALF)); __builtin_nontemporal_store(s2, (PG8_GAS f32x4*)(xout + offB + bj * HALF)); }
                    if (xb) { u32x4 w; w.x = cvt_pk_bf16(v0[0], v0[1]); w.y = cvt_pk_bf16(v0[2], v0[3]); w.z = cvt_pk_bf16(v1[0], v1[1]); w.w = cvt_pk_bf16(v1[2], v1[3]); *(PG8_GAS u32x4*)(xb + off + bj * HALF) = w;
                        const f32x4 q0 = v0 * v0, q1 = v1 * v1; ss += ((q0[0] + q0[1]) + (q0[2] + q0[3])) + ((q1[0] + q1[1]) + (q1[2] + q1[3])); } }
                if (xb) { ss += __shfl_xor(ss, 16); ss += __shfl_xor(ss, 32); if (fq == 0) __hip_atomic_fetch_add((PG8_GAS float*)(ssq + r), ss, __ATOMIC_RELAXED, __HIP_MEMORY_SCOPE_AGENT); }
            }
    }
};

struct EpiNull {
    static constexpr bool PERM = true, AFTER_DRAIN = false;
    __device__ __forceinline__ void prefetch(PG8_LAS unsigned char*, const Unit&, int, int, int) const {}
    __device__ __forceinline__ void operator()(const f32x4 (&acc)[2][2][4][2], const Unit& u, int wr, int wc, int fr, int fq, PG8_LAS unsigned char*, int) const {
#pragma unroll
        for (int ai = 0; ai < 2; ++ai)
#pragma unroll
            for (int bj = 0; bj < 2; ++bj)
#pragma unroll
                for (int m = 0; m < 4; ++m)
#pragma unroll
                    for (int n = 0; n < 2; ++n) asm volatile("" :: "v"(acc[ai][bj][m][n]));
    }
};
struct EpiPlain {
    static constexpr bool PERM = true, AFTER_DRAIN = false;
    bf16_t* P; int ldc;
    __device__ __forceinline__ void prefetch(PG8_LAS unsigned char*, const Unit&, int, int, int) const {}
    __device__ __forceinline__ void operator()(const f32x4 (&acc)[2][2][4][2], const Unit& u, int wr, int wc, int fr, int fq, PG8_LAS unsigned char*, int) const {
        const int lcol = u.pn * 256 + 64 * wc + 8 * fq;
#pragma unroll
        for (int bj = 0; bj < 2; ++bj)
#pragma unroll
            for (int ai = 0; ai < 2; ++ai)
#pragma unroll
                for (int m = 0; m < 4; ++m) { const int r = u.pm * BM + ai * HALF + wr * 64 + m * 16 + fr; const f32x4 v0 = acc[ai][bj][m][0], v1 = acc[ai][bj][m][1];
                    u32x4 w; w.x = cvt_pk_bf16(v0[0], v0[1]); w.y = cvt_pk_bf16(v0[2], v0[3]); w.z = cvt_pk_bf16(v1[0], v1[1]); w.w = cvt_pk_bf16(v1[2], v1[3]);
                    *(PG8_GAS u32x4*)(P + (size_t)r * ldc + lcol + 32 * bj) = w; }
    }
};
template <class Epi, class Sched, bool ALIGN_EPI = false, bool SP2 = false>
__device__ __forceinline__ void gemm_phase(PG8_LAS unsigned char* lds, PG8_LAS unsigned char* aux, const Gemm g, const Sched& S, const Epi& E) {
    int tid_ = threadIdx.x; asm volatile("" : "+v"(tid_));
    const int tid = tid_, wid = __builtin_amdgcn_readfirstlane(tid >> 6), lane = tid & 63, wr = wid >> 2, wc = wid & 3, fr = lane & 15, fq = lane >> 4;
    const int K = g.K, nt = K / BK;
    unsigned voffA[2], voffB[2];
#pragma unroll
    for (int i = 0; i < 2; ++i) { int R, C; stage_rc(tid * 16 + i * 8192, R, C); const int Rb = Epi::PERM ? ((R & ~31) + perm32(R & 31)) : R;
        voffA[i] = (unsigned)(R * K + C) * 2u; voffB[i] = (unsigned)(Rb * K + C) * 2u; }
    const size_t kstep = (size_t)(BK * 2);
    const size_t hstep = (size_t)HALF * K * 2;
    const size_t tstep = 2 * hstep;
    const unsigned ldsw = (unsigned)wid * 1024u;
    const int aoff = lds_byte(wr * 64 + fr, fq * 8), boff = lds_byte(wc * 32 + fr, fq * 8);
#define PG8_SA(b, h) (((b) * 2 + (h)) * HTB)
#define PG8_SB(b, h) ((4 + (b) * 2 + (h)) * HTB)
#define PG8_STAGE(bufoff, gbase, voff) do { _Pragma("unroll") for (int _i = 0; _i < 2; ++_i) \
        __builtin_amdgcn_global_load_lds((const unsigned*)((const char*)(gbase) + (voff)[_i]), (PG8_LAS unsigned*)(lds + (bufoff) + ldsw + _i * 8192), 16, 0, 0); } while (0)
#define PG8_LDA(dst, b, h) do { _Pragma("unroll") for (int m = 0; m < 4; ++m) _Pragma("unroll") for (int k = 0; k < 2; ++k) dst[m][k] = *(const PG8_LAS bf16x8*)(lds + PG8_SA(b, h) + aoff + m * 2048 + k * 1024); } while (0)
#define PG8_LDB(dst, b, h) do { _Pragma("unroll") for (int n = 0; n < 2; ++n) _Pragma("unroll") for (int k = 0; k < 2; ++k) dst[n][k] = *(const PG8_LAS bf16x8*)(lds + PG8_SB(b, h) + boff + n * 2048 + k * 1024); } while (0)
#define PG8_MMA(ai, bj, At, Bt) do { __builtin_amdgcn_s_setprio(1); _Pragma("unroll") for (int m = 0; m < 4; ++m) _Pragma("unroll") for (int n = 0; n < 2; ++n) _Pragma("unroll") for (int k = 0; k < 2; ++k) \
        acc[ai][bj][m][n] = __builtin_amdgcn_mfma_f32_16x16x32_bf16(Bt[n][k], At[m][k], acc[ai][bj][m][n], 0, 0, 0); __builtin_amdgcn_s_setprio(0); } while (0)
#define PG8_WAIT_V(n) asm volatile("s_waitcnt vmcnt(" #n ")" ::: "memory")
#define PG8_WAIT_L(n) asm volatile("s_waitcnt lgkmcnt(" #n ")" ::: "memory")
#define PG8_BAR __builtin_amdgcn_s_barrier()
#define PG8_SCHED __builtin_amdgcn_sched_barrier(0)
    Unit cur, nxt; int ui = 0;
    if (!S.next(0, cur)) return;
    f32x4 acc[2][2][4][2];
#pragma unroll
    for (int a = 0; a < 2; ++a)
#pragma unroll
        for (int b = 0; b < 2; ++b)
#pragma unroll
            for (int m = 0; m < 4; ++m)
#pragma unroll
                for (int n = 0; n < 2; ++n) acc[a][b][m][n] = (f32x4){0.f, 0.f, 0.f, 0.f};
    bf16x8 At[4][2], B0[2][2], B1[2][2];
    const char* cA = (const char*)g.A + (size_t)cur.pm * tstep; const char* cB = (const char*)g.Bt + (size_t)cur.pn * tstep;
    S.a_ready(cur); E.prefetch(aux, cur, 0, wid, lane);
    if constexpr (SP2) {
        PG8_STAGE(PG8_SB(0, 0), cB, voffB); PG8_STAGE(PG8_SB(0, 1), cB + hstep, voffB); PG8_STAGE(PG8_SA(0, 0), cA, voffA); PG8_STAGE(PG8_SA(0, 1), cA + hstep, voffA);
        if (wr == 1) PG8_BAR;
        PG8_WAIT_V(2); PG8_BAR;
        PG8_STAGE(PG8_SB(1, 0), cB + kstep, voffB); PG8_STAGE(PG8_SA(1, 0), cA + kstep, voffA); PG8_STAGE(PG8_SB(1, 1), cB + hstep + kstep, voffB);
        PG8_WAIT_V(6); PG8_BAR;
    } else {
        PG8_STAGE(PG8_SB(0, 0), cB, voffB); PG8_STAGE(PG8_SA(0, 0), cA, voffA); PG8_STAGE(PG8_SB(0, 1), cB + hstep, voffB); PG8_STAGE(PG8_SA(0, 1), cA + hstep, voffA);
        if (wr == 1) PG8_BAR;
        PG8_WAIT_V(4); PG8_BAR;
        PG8_STAGE(PG8_SB(1, 0), cB + kstep, voffB); PG8_STAGE(PG8_SA(1, 0), cA + kstep, voffA); PG8_STAGE(PG8_SB(1, 1), cB + hstep + kstep, voffB);
        PG8_WAIT_V(6); PG8_BAR;
    }
    for (;;) {
        const bool has_next = S.next(ui + 1, nxt);
        const char* nA = has_next ? (const char*)g.A + (size_t)nxt.pm * tstep : cA; const char* nB = has_next ? (const char*)g.Bt + (size_t)nxt.pn * tstep : cB;
        for (int t = 0; t < nt; t += 2) {
            const bool last = (t == nt - 2);
            const char* a1 = cA + (size_t)(t + 1) * kstep;
            const char* a2 = last ? nA : cA + (size_t)(t + 2) * kstep; const char* b2 = last ? nB : cB + (size_t)(t + 2) * kstep;
            const char* a3 = a2 + kstep; const char* b3 = b2 + kstep;
            if (last && has_next) { S.a_ready(nxt); E.prefetch(aux, nxt, ui + 1, wid, lane); }
            if constexpr (SP2) {
            PG8_LDB(B0, 0, 0); PG8_LDB(B1, 0, 1); PG8_SCHED; PG8_LDA(At, 0, 0); PG8_STAGE(PG8_SA(1, 1), a1 + hstep, voffA);
            PG8_WAIT_V(8); PG8_WAIT_L(0); PG8_BAR; PG8_MMA(0, 0, At, B0); PG8_MMA(0, 1, At, B1); PG8_BAR; PG8_SCHED;
            PG8_LDA(At, 0, 1); PG8_STAGE(PG8_SB(0, 0), b2, voffB); PG8_STAGE(PG8_SB(0, 1), b2 + hstep, voffB); PG8_STAGE(PG8_SA(0, 0), a2, voffA);
            PG8_WAIT_V(8); PG8_WAIT_L(0); PG8_BAR; PG8_MMA(1, 0, At, B0); PG8_MMA(1, 1, At, B1); PG8_BAR; PG8_SCHED;
            PG8_LDB(B0, 1, 0); PG8_LDB(B1, 1, 1); PG8_SCHED; PG8_LDA(At, 1, 0); PG8_STAGE(PG8_SA(0, 1), a2 + hstep, voffA);
            PG8_WAIT_V(8); PG8_WAIT_L(0); PG8_BAR; PG8_MMA(0, 0, At, B0); PG8_MMA(0, 1, At, B1); PG8_BAR; PG8_SCHED;
            PG8_LDA(At, 1, 1); PG8_STAGE(PG8_SB(1, 0), b3, voffB); PG8_STAGE(PG8_SB(1, 1), b3 + hstep, voffB); PG8_STAGE(PG8_SA(1, 0), a3, voffA);
            PG8_WAIT_V(8); PG8_WAIT_L(0); PG8_BAR; PG8_MMA(1, 0, At, B0); PG8_MMA(1, 1, At, B1); PG8_BAR; PG8_SCHED;
            } else {
            PG8_LDB(B0, 0, 0); PG8_SCHED; PG8_LDA(At, 0, 0); PG8_STAGE(PG8_SA(1, 1), a1 + hstep, voffA);
            PG8_WAIT_L(8); PG8_BAR; PG8_WAIT_L(0); PG8_MMA(0, 0, At, B0); PG8_BAR; PG8_SCHED;
            PG8_LDB(B1, 0, 1); PG8_STAGE(PG8_SB(0, 0), b2, voffB);
            PG8_BAR; PG8_WAIT_L(0); PG8_MMA(0, 1, At, B1); PG8_BAR;
            PG8_LDA(At, 0, 1); PG8_STAGE(PG8_SA(0, 0), a2, voffA);
            PG8_BAR; PG8_WAIT_L(0); PG8_MMA(1, 0, At, B0); PG8_BAR; PG8_SCHED;
            PG8_STAGE(PG8_SB(0, 1), b2 + hstep, voffB);
            PG8_WAIT_V(6); PG8_BAR; PG8_MMA(1, 1, At, B1); PG8_BAR;
            PG8_LDB(B0, 1, 0); PG8_SCHED; PG8_LDA(At, 1, 0); PG8_STAGE(PG8_SA(0, 1), a2 + hstep, voffA);
            PG8_WAIT_L(8); PG8_BAR; PG8_WAIT_L(0); PG8_MMA(0, 0, At, B0); PG8_BAR; PG8_SCHED;
            PG8_LDB(B1, 1, 1); PG8_STAGE(PG8_SB(1, 0), b3, voffB);
            PG8_BAR; PG8_WAIT_L(0); PG8_MMA(0, 1, At, B1); PG8_BAR;
            PG8_LDA(At, 1, 1); PG8_STAGE(PG8_SA(1, 0), a3, voffA);
            PG8_BAR; PG8_WAIT_L(0); PG8_MMA(1, 0, At, B0); PG8_BAR; PG8_SCHED;
            PG8_STAGE(PG8_SB(1, 1), b3 + hstep, voffB);
            PG8_WAIT_V(6); PG8_BAR; PG8_MMA(1, 1, At, B1); PG8_BAR;
            }
        }
        if constexpr (ALIGN_EPI) { if (wr == 0) PG8_BAR; }
        if constexpr (!Epi::AFTER_DRAIN) { E(acc, cur, wr, wc, fr, fq, aux, ui); S.done(cur); }
        if (!has_next) break;
#pragma unroll
        for (int a = 0; a < 2; ++a)
#pragma unroll
            for (int b = 0; b < 2; ++b)
#pragma unroll
                for (int m = 0; m < 4; ++m)
#pragma unroll
                    for (int n = 0; n < 2; ++n) acc[a][b][m][n] = (f32x4){0.f, 0.f, 0.f, 0.f};
        cur = nxt; cA = nA; cB = nB; ++ui;
        if constexpr (ALIGN_EPI) { if (wr == 1) PG8_BAR; }
    }
    PG8_WAIT_V(0);
    if constexpr (!ALIGN_EPI) { if (wr == 0) PG8_BAR; }
    PG8_BAR;
    if constexpr (Epi::AFTER_DRAIN) { E.fused(acc, cur, wr, wc, fr, fq, lds, wid, lane); S.done(cur); }
#undef PG8_SA
#undef PG8_SB
#undef PG8_STAGE
#undef PG8_LDA
#undef PG8_LDB
#undef PG8_MMA
#undef PG8_WAIT_V
#undef PG8_WAIT_L
#undef PG8_BAR
#undef PG8_SCHED
}
}
#define GAS __attribute__((address_space(1)))
#define LAS __attribute__((address_space(3)))
typedef unsigned short bf16;
typedef unsigned v4u __attribute__((ext_vector_type(4)));
typedef float f32x4 __attribute__((ext_vector_type(4)));
typedef short bf16x8 __attribute__((ext_vector_type(8)));
typedef GAS unsigned gu32;
typedef GAS unsigned long long gu64;
#define RLX_AGENT __ATOMIC_RELAXED, __HIP_MEMORY_SCOPE_AGENT
#define LDS_WAIT() asm volatile("s_waitcnt lgkmcnt(0)" ::: "memory")
#define VM_WAIT() asm volatile("s_waitcnt vmcnt(0)" ::: "memory")
__device__ __forceinline__ unsigned long long rt() { return __builtin_amdgcn_s_memrealtime(); }
__device__ __forceinline__ unsigned f2bf(float f) { unsigned u = __builtin_bit_cast(unsigned, f); return (u + 0x7fffu + ((u >> 16) & 1u)) >> 16; }
__device__ __forceinline__ unsigned pk2(float lo, float hi) { return f2bf(lo) | (f2bf(hi) << 16); }

#define XB_TMO      128
#define XB_XCNT(j)  (256  + 64 * (j))
#define XB_XSUB(j)  (1280 + 64 * (j))
#define XB_XGEN(j)  (2304 + 64 * (j))
#define XB_TOP      3328
#define XB_TOPGEN   3392
#define XCD_BAR_WORDS 3456
#define XB_SPIN_CAP (1u << 18)

__device__ __forceinline__ unsigned xb_ld(unsigned* p)              { return __hip_atomic_load(p, __ATOMIC_RELAXED, __HIP_MEMORY_SCOPE_AGENT); }
__device__ __forceinline__ unsigned xb_add(unsigned* p, unsigned v) { return __hip_atomic_fetch_add(p, v, __ATOMIC_RELAXED, __HIP_MEMORY_SCOPE_AGENT); }
__device__ __forceinline__ unsigned xb_xcc_id() { return (unsigned)__builtin_amdgcn_s_getreg((3 << 11) | 20) & 0xFu; }
#define XB_SPIN(cond, bar) do { unsigned _sp = 0; while (cond) { __builtin_amdgcn_s_sleep(1); \
    if ((++_sp & 255u) == 0u) { if (xb_ld(&(bar)[XB_TMO])) break; if (_sp > XB_SPIN_CAP) { atomicAdd(&(bar)[XB_TMO], 1u); break; } } } } while (0)

struct XcdBarrier {
    unsigned* bar; unsigned x;
    volatile LAS unsigned* st;
};

__device__ __forceinline__ XcdBarrier xcd_barrier_post(unsigned* bar, volatile LAS unsigned* st) {
    XcdBarrier b; b.bar = bar; b.x = xb_xcc_id(); b.st = st;
    if (threadIdx.x == 0) (void)xb_add(&bar[XB_XCNT(b.x)], 1u);
    return b;
}
__device__ __forceinline__ void xcd_barrier_complete(unsigned* bar, unsigned x, unsigned& nloc, unsigned& nx) {
    const unsigned G = gridDim.x * gridDim.y * gridDim.z;
    unsigned sum, cnt, mine, sp = 0u;
    for (;;) {
        sum = 0u; cnt = 0u; mine = 0u;
#pragma unroll
        for (unsigned j = 0; j < 16; ++j) { const unsigned c = xb_ld(&bar[XB_XCNT(j)]); sum += c; cnt += (c > 0u) ? 1u : 0u; mine = (j == x) ? c : mine; }
        if (sum == G) break;
        __builtin_amdgcn_s_sleep(1);
        if ((++sp & 255u) == 0u) { if (xb_ld(&bar[XB_TMO])) break; if (sp > XB_SPIN_CAP) { atomicAdd(&bar[XB_TMO], 1u); break; } }
    }
    nloc = mine > 0u ? mine : 1u; nx = cnt > 0u ? cnt : 1u;
}

__device__ __forceinline__ void xcd_barrier(const XcdBarrier& b) {
    asm volatile("s_waitcnt vmcnt(0)" ::: "memory");
    __syncthreads();
    if (threadIdx.x == 0) {
        unsigned* bar = b.bar;
        __builtin_amdgcn_s_waitcnt(0);
        unsigned nloc = b.st[0], nx = b.st[1];
        if (nloc == 0u) { xcd_barrier_complete(bar, b.x, nloc, nx); b.st[0] = nloc; b.st[1] = nx; }
        const unsigned old = xb_add(&bar[XB_XSUB(b.x)], 1u);
        const unsigned gen = old / nloc;
        if (old + 1u == (gen + 1u) * nloc) {
            __builtin_amdgcn_fence(__ATOMIC_RELEASE, "agent");
            asm volatile("s_waitcnt vmcnt(0)" ::: "memory");
            const unsigned og = xb_add(&bar[XB_TOP], 1u);
            const unsigned tg = og / nx;
            if (og + 1u == (tg + 1u) * nx) xb_add(&bar[XB_TOPGEN], 1u);
            else XB_SPIN(xb_ld(&bar[XB_TOPGEN]) == tg, bar);
            __builtin_amdgcn_fence(__ATOMIC_ACQUIRE, "agent");
            xb_add(&bar[XB_XGEN(b.x)], 1u);
            asm volatile("s_waitcnt vmcnt(0)" ::: "memory");
        } else {
            XB_SPIN(xb_ld(&bar[XB_XGEN(b.x)]) == gen, bar);
            __builtin_amdgcn_fence(__ATOMIC_ACQUIRE, "agent");
            asm volatile("s_waitcnt vmcnt(0)" ::: "memory");
        }
    }
    __syncthreads();
}
namespace moba_body {
typedef unsigned short bf16;
using bf16x8=__attribute__((ext_vector_type(8)))short;
using s16x4=__attribute__((ext_vector_type(4)))short;
using f32x16=__attribute__((ext_vector_type(16)))float;
using f32x4=__attribute__((ext_vector_type(4)))float;
using u32x4=__attribute__((ext_vector_type(4)))unsigned;
#define MB_GAS __attribute__((address_space(1)))
#define MB_LAS __attribute__((address_space(3)))
constexpr int D=64,NHEAD=4,PITCH=NPROJ,YPITCH=DM;
constexpr int NW=8,QBLK=32,QB=QBLK*NW,KVBLK=64,NQB=SEQ/QB;
__device__ __forceinline__ int crow(int r,int hi){return (r&3)+8*(r>>2)+4*hi;}
#define SBAR() __builtin_amdgcn_sched_barrier(0)
__device__ __forceinline__ void cmask(f32x16&p0,f32x16&p1,int jb,int qrel,int hi){
  const float NEG=-INFINITY; int kb=64*jb+4*hi;
  #pragma unroll
  for(int r=0;r<16;++r){int kv=kb+(r&3)+8*(r>>2); if(kv>qrel)p0[r]=NEG; if(kv+32>qrel)p1[r]=NEG;}
}
constexpr int NSLOT=3, SLOTB=8192;
constexpr int LDS_K=0, LDS_V=NSLOT*SLOTB, LDS_WS=2*NSLOT*SLOTB, LDS_OST=LDS_WS+NW*64*4, LDS_BYTES=LDS_OST+NW*4096;
constexpr float LOG2E=1.4426950408889634f;
__device__ __forceinline__ void glds16(const void*gsrc,unsigned lds_dst){unsigned keep;
  asm volatile("s_mov_b32 %0, m0\n\ts_mov_b32 m0, %2\n\ts_nop 0\n\tglobal_load_lds_dwordx4 %1, off\n\ts_mov_b32 m0, %0":"=&s"(keep):"v"(gsrc),"s"(lds_dst):"memory");}
typedef float f32x2_t __attribute__((ext_vector_type(2))); typedef __bf16 bf16x2_t __attribute__((ext_vector_type(2)));
__device__ __forceinline__ unsigned cvtpk_s(float lo,float hi){f32x2_t v={lo,hi};bf16x2_t b=__builtin_convertvector(v,bf16x2_t);return __builtin_bit_cast(unsigned,b);}
__device__ __forceinline__ float bfround(float x){ return __uint_as_float(cvtpk_s(x,0.f)<<16); }
#define WAIT_BAR(N) asm volatile("s_waitcnt vmcnt(" #N ") lgkmcnt(0)\n\ts_barrier":::"memory")
#define MFMA32(a,b,c) __builtin_amdgcn_mfma_f32_32x32x16_bf16(a,b,c,0,0,0)
typedef __attribute__((address_space(3))) const char* lds_cptr;
typedef short v4i16_t __attribute__((ext_vector_type(4)));
__device__ __forceinline__ void kload8(bf16x8*kf,lds_cptr kp){
  kf[0]=*(const __attribute__((address_space(3))) bf16x8*)(kp);      kf[1]=*(const __attribute__((address_space(3))) bf16x8*)(kp+512);
  kf[2]=*(const __attribute__((address_space(3))) bf16x8*)(kp+2048); kf[3]=*(const __attribute__((address_space(3))) bf16x8*)(kp+2560);
  kf[4]=*(const __attribute__((address_space(3))) bf16x8*)(kp+4096); kf[5]=*(const __attribute__((address_space(3))) bf16x8*)(kp+4608);
  kf[6]=*(const __attribute__((address_space(3))) bf16x8*)(kp+6144); kf[7]=*(const __attribute__((address_space(3))) bf16x8*)(kp+6656);
}
__device__ __forceinline__ void kload2(bf16x8*kf,lds_cptr kp,int j){ kf[2*j]=*(const __attribute__((address_space(3))) bf16x8*)(kp+j*2048); kf[2*j+1]=*(const __attribute__((address_space(3))) bf16x8*)(kp+j*2048+512); }
__device__ __forceinline__ s16x4 vtr(lds_cptr p){ return __builtin_bit_cast(s16x4,__builtin_amdgcn_ds_read_tr16_b64_v4i16((__attribute__((address_space(3))) v4i16_t*)p)); }
#define MX3(a,b,c) __builtin_fmaxf(__builtin_fmaxf((a),(b)),(c))
__device__ __forceinline__ float rowmax(const f32x16&p0,const f32x16&p1){
  float a=MX3(p0[0],p0[1],p1[0]),b=MX3(p0[2],p0[3],p1[1]);a=MX3(a,p1[2],p1[3]);
  #pragma unroll
  for(int r=4;r<16;r+=4){a=MX3(a,p0[r],p0[r+1]);b=MX3(b,p0[r+2],p0[r+3]);a=MX3(a,p1[r],p1[r+1]);b=MX3(b,p1[r+2],p1[r+3]);}
  const float m=__builtin_fmaxf(a,b);
  auto rr=__builtin_amdgcn_permlane32_swap(__float_as_uint(m),__float_as_uint(m),false,false);
  return __builtin_fmaxf(__uint_as_float(rr[0]),__uint_as_float(rr[1]));
}
__device__ __forceinline__ void pv(f32x16*o,int vb,bf16x8 pa0,bf16x8 pa1,bf16x8 pa2,bf16x8 pa3){
  #pragma unroll
  for(int d0=0;d0<2;++d0){s16x4 lo[4],hi[4];
    #pragma unroll
    for(int ks=0;ks<4;++ks){
      asm volatile("ds_read_b64_tr_b16 %0,%1 offset:%c2":"=&v"(lo[ks]):"v"(vb),"i"(d0*4096+ks*1024):"memory");
      asm volatile("ds_read_b64_tr_b16 %0,%1 offset:%c2":"=&v"(hi[ks]):"v"(vb),"i"(d0*4096+ks*1024+512):"memory");}
    asm volatile("s_waitcnt lgkmcnt(0)":::"memory");SBAR();
    #define PK(k) (bf16x8){lo[k][0],lo[k][1],lo[k][2],lo[k][3],hi[k][0],hi[k][1],hi[k][2],hi[k][3]}
    o[d0]=MFMA32(pa0,PK(0),o[d0]);
    o[d0]=MFMA32(pa1,PK(1),o[d0]);
    o[d0]=MFMA32(pa2,PK(2),o[d0]);
    o[d0]=MFMA32(pa3,PK(3),o[d0]);
    #undef PK
  }
}
template<int NT,int MODE> __device__ __forceinline__ void chunk_attn(f32x16*o,float&l,const bf16x8*qr,u32x4&ka,const u32x4&qa0,const u32x4&qa1,unsigned hm,float dTb,lds_cptr kp0,lds_cptr vp0,int tile0,int r32,int hi,int qd){
  #define CK_SETDT(t) do{ const float d_=dTb+(float)(64*(tile0+(t))); ka[1]=cvtpk_s(d_,d_)&hm; }while(0)
  #define CK_KA __builtin_bit_cast(bf16x8,ka)
  #define CK_MASK(C0,C1,t) do{ if(MODE==1&&(t)==NT-1){ _Pragma("unroll") for(int r=0;r<16;++r){ const int kv=crow(r,hi); if(kv>qd)C0[r]=-INFINITY; if(kv+32>qd)C1[r]=-INFINITY; } } \
      if(MODE==2){ const int kb_=64*(tile0+(t)); _Pragma("unroll") for(int r=0;r<16;++r){ const int kk=kb_+crow(r,hi); if(kk>qd||kk<qd-127)C0[r]=-INFINITY; if(kk+32>qd||kk+32<qd-127)C1[r]=-INFINITY; } } }while(0)
  bf16x8 kf[8]; s16x4 vlo[8],vhi[8]; u32x4 pw0,pw1,pw2,pw3; f32x16 pA0,pA1,pB0,pB1;
  #define PKW(P,B) cvtpk_s(P[B],P[B+1])
  #define PAF(k) __builtin_bit_cast(bf16x8,pw##k)
  #define VFR(i) (bf16x8){vlo[i][0],vlo[i][1],vlo[i][2],vlo[i][3],vhi[i][0],vhi[i][1],vhi[i][2],vhi[i][3]}
  #define PIN(x) asm volatile("":"+v"(x))
  #define GAPA(MF,A0,A1,A2,A3,W0,W1,PW) do{ MF; sacc+=A0; sacc+=A1; sacc+=A2; sacc+=A3; PIN(sacc); W0; W1; PIN(PW); SBAR(); }while(0)
  #define EX(v) __builtin_amdgcn_exp2f(v)
  #define GAPB(MF,X,B) do{ MF; X[B]=EX(X[B]); X[B+1]=EX(X[B+1]); X[B+2]=EX(X[B+2]); X[B+3]=EX(X[B+3]); PIN(X); SBAR(); }while(0)
  #define VRD(i) do{ vlo[i]=vtr(vp_+(((i)>>2)*4096+((i)&3)*1024)); vhi[i]=vtr(vp_+(((i)>>2)*4096+((i)&3)*1024+512)); }while(0)
  #define KRD(G,t,j) do{ if(G){ kload2(kf,kp0+(tile0+(t)+1)*SLOTB,j); SBAR(); } }while(0)
  #define CK_STEP(C0,C1,P0,P1,t,GL) do{ SBAR(); \
    const lds_cptr vp_=vp0+(tile0+(t)-1)*SLOTB; CK_SETDT(t); \
    C0=MFMA32(CK_KA,__builtin_bit_cast(bf16x8,qa0),f32x16{}); C1=MFMA32(CK_KA,__builtin_bit_cast(bf16x8,qa1),f32x16{}); SBAR(); \
    VRD(0); SBAR(); float sacc=(P0[0]+P0[1]); \
    GAPA(C0=MFMA32(kf[0],qr[0],C0), P0[2],P0[3],P0[4],P0[5],     pw0[0]=PKW(P0,0), pw0[1]=PKW(P0,2), pw0); \
    VRD(4); SBAR(); GAPA(C1=MFMA32(kf[1],qr[0],C1), P0[6],P0[7],P0[8],P0[9],     pw0[2]=PKW(P0,4), pw0[3]=PKW(P0,6), pw0); \
    VRD(1); SBAR(); GAPA(C0=MFMA32(kf[2],qr[1],C0),   P0[10],P0[11],P0[12],P0[13], pw1[0]=PKW(P0,8), pw1[1]=PKW(P0,10), pw1); \
    VRD(5); SBAR(); GAPA(C1=MFMA32(kf[3],qr[1],C1),   P0[14],P0[15],P1[0],P1[1],   pw1[2]=PKW(P0,12),pw1[3]=PKW(P0,14), pw1); \
    VRD(2); SBAR(); GAPA(C0=MFMA32(kf[4],qr[2],C0),   P1[2],P1[3],P1[4],P1[5],     pw2[0]=PKW(P1,0), pw2[1]=PKW(P1,2), pw2); \
    VRD(6); SBAR(); GAPA(C1=MFMA32(kf[5],qr[2],C1),   P1[6],P1[7],P1[8],P1[9],     pw2[2]=PKW(P1,4), pw2[3]=PKW(P1,6), pw2); \
    VRD(3); SBAR(); GAPA(C0=MFMA32(kf[6],qr[3],C0),   P1[10],P1[11],P1[12],P1[13], pw3[0]=PKW(P1,8), pw3[1]=PKW(P1,10), pw3); \
    VRD(7); SBAR(); GAPA(C1=MFMA32(kf[7],qr[3],C1),   P1[14],P1[15],0.f,0.f,       pw3[2]=PKW(P1,12),pw3[3]=PKW(P1,14), pw3); \
    l+=sacc; \
    CK_MASK(C0,C1,t); \
    SBAR(); \
    GAPB(o[0]=MFMA32(PAF(0),VFR(0),o[0]), C0,0); \
    GAPB(o[1]=MFMA32(PAF(0),VFR(4),o[1]), C0,4); \
    KRD(GL,t,0); GAPB(o[0]=MFMA32(PAF(1),VFR(1),o[0]), C0,8); \
    KRD(GL,t,1); GAPB(o[1]=MFMA32(PAF(1),VFR(5),o[1]), C0,12); \
    KRD(GL,t,2); GAPB(o[0]=MFMA32(PAF(2),VFR(2),o[0]), C1,0); \
    KRD(GL,t,3); GAPB(o[1]=MFMA32(PAF(2),VFR(6),o[1]), C1,4); \
    GAPB(o[0]=MFMA32(PAF(3),VFR(3),o[0]), C1,8); \
    GAPB(o[1]=MFMA32(PAF(3),VFR(7),o[1]), C1,12); \
    }while(0)
  #define CK_DRAIN(P0,P1,t) do{ float sacc=P0[0]+P0[1]; _Pragma("unroll") for(int r=2;r<16;++r)sacc+=P0[r]; _Pragma("unroll") for(int r=0;r<16;++r)sacc+=P1[r]; l+=sacc; \
    pw0=(u32x4){PKW(P0,0),PKW(P0,2),PKW(P0,4),PKW(P0,6)};pw1=(u32x4){PKW(P0,8),PKW(P0,10),PKW(P0,12),PKW(P0,14)};pw2=(u32x4){PKW(P1,0),PKW(P1,2),PKW(P1,4),PKW(P1,6)};pw3=(u32x4){PKW(P1,8),PKW(P1,10),PKW(P1,12),PKW(P1,14)}; \
    const lds_cptr vp_=vp0+(tile0+(t))*SLOTB; _Pragma("unroll") for(int i=0;i<8;++i)VRD(i); \
    o[0]=MFMA32(PAF(0),VFR(0),o[0]); o[1]=MFMA32(PAF(0),VFR(4),o[1]); o[0]=MFMA32(PAF(1),VFR(1),o[0]); o[1]=MFMA32(PAF(1),VFR(5),o[1]); \
    o[0]=MFMA32(PAF(2),VFR(2),o[0]); o[1]=MFMA32(PAF(2),VFR(6),o[1]); o[0]=MFMA32(PAF(3),VFR(3),o[0]); o[1]=MFMA32(PAF(3),VFR(7),o[1]); }while(0)
  CK_SETDT(0); kload8(kf,kp0+tile0*SLOTB);
  pA0=MFMA32(CK_KA,__builtin_bit_cast(bf16x8,qa0),f32x16{}); pA1=MFMA32(CK_KA,__builtin_bit_cast(bf16x8,qa1),f32x16{});
  #pragma unroll
  for(int d0=0;d0<4;++d0){ pA0=MFMA32(kf[2*d0],qr[d0],pA0); pA1=MFMA32(kf[2*d0+1],qr[d0],pA1); }
  CK_MASK(pA0,pA1,0);
  if(NT>1){ SBAR(); kload8(kf,kp0+(tile0+1)*SLOTB); }
  #pragma unroll
  for(int r=0;r<16;++r){ pA0[r]=EX(pA0[r]); pA1[r]=EX(pA1[r]); }
  if(NT>1){ CK_STEP(pB0,pB1,pA0,pA1,1,(NT>2)); }
  if(NT>2){ CK_STEP(pA0,pA1,pB0,pB1,2,(NT>3)); }
  if(NT>3){ CK_STEP(pB0,pB1,pA0,pA1,3,false); }
  if(NT==1||NT==3){ CK_DRAIN(pA0,pA1,NT-1); } else { CK_DRAIN(pB0,pB1,NT-1); }
  #undef CK_SETDT
  #undef CK_KA
  #undef CK_MASK
  #undef PKW
  #undef PAF
  #undef VFR
  #undef PIN
  #undef GAPA
  #undef EX
  #undef GAPB
  #undef VRD
  #undef KRD
  #undef CK_STEP
  #undef CK_DRAIN
}
constexpr int GS_QP=0, GS_TJ=4352, GS_PRE=4480, GS_RNG=4736, GS_WSF=4864, GS_DST=6912, GS_STG=8192, GS_C=16384, GS_BYTES=20480;
__device__ __forceinline__ u32x4 stage8(const f32x16*o,const MB_LAS float*wsf,MB_LAS bf16*stg,int k,int lane,int r32,int hi){
  #pragma unroll
  for(int rr=0;rr<4;++rr){ const int r=4*k+rr, lrow=rr+4*hi; const float ri=wsf[32+crow(r,hi)];
    #pragma unroll
    for(int d0=0;d0<2;++d0)stg[lrow*64+d0*32+r32]=(bf16)(cvtpk_s(o[d0][r]*ri,0.f)&0xffffu);}
  asm volatile("s_waitcnt lgkmcnt(0)":::"memory");
  const u32x4 v=*(const MB_LAS u32x4*)(stg+(lane>>3)*64+(lane&7)*8);
  asm volatile("s_waitcnt lgkmcnt(0)":::"memory");
  return v;
}
__device__ __forceinline__ void swa_phase(char*shm,char*scr,const bf16*P,const float*sinks,bf16*Y,int vcu,int G){
  int tid_=threadIdx.x; asm volatile("":"+v"(tid_));
  const int tid=tid_,lane=tid&63,r32=lane&31,hi=lane>>5; const int wid=__builtin_amdgcn_readfirstlane(tid>>6);
  if(wid>=4)__builtin_amdgcn_s_setprio(1);
  const int g=wid>>2,qs=32*(wid&3),tl=(qs>=64)?1:0;
  const unsigned lds0=(unsigned)(uintptr_t)shm;
  MB_LAS float*wsf=(MB_LAS float*)(scr+GS_WSF)+wid*64; MB_LAS bf16*stg=(MB_LAS bf16*)(scr+GS_STG)+wid*512;
  const lds_cptr shm3=(lds_cptr)shm; const lds_cptr vp0=shm3+4*SLOTB+((lane>>4)&1)*32+(lane&3)*8+(4*hi+((lane&15)>>2))*64; const lds_cptr kp0=shm3+hi*1024+r32*16;
  const unsigned kdst=lds0+wid*1024, vdst=lds0+4*SLOTB+wid*1024;
  const unsigned hm=hi?0u:0xffffffffu; const float Lh=bfround(LOG2E),Ll=bfround(LOG2E-Lh);
  const int NU=NB*2*(SEQ/128);
  #define SWA_DMA(U,BUF) do{ const int n_=(U)&63,kv_=((U)>>6)&1,b_=(U)>>7; const long key0_=128L*(n_-1); const int tf_=(n_==0)?2:0; \
      const bf16*ks_=P+OFF_KC+((size_t)(b_*2+kv_)*SEQ+key0_+lane)*64+wid*8; const bf16*vs_=P+OFF_VC+((size_t)(b_*2+kv_)*SEQ+key0_+16*(wid&3)+(lane>>2))*64+(wid>>2)*32+(lane&3)*8; \
      _Pragma("unroll") for(int t=0;t<4;++t) if(t>=tf_){ glds16(ks_+(long)t*KVBLK*64,(unsigned)__builtin_amdgcn_readfirstlane(kdst+(BUF)*65536+t*SLOTB)); glds16(vs_+(long)t*KVBLK*64,(unsigned)__builtin_amdgcn_readfirstlane(vdst+(BUF)*65536+t*SLOTB)); } }while(0)
  #define SWA_Q(U,QO) do{ const int n_=(U)&63,kv_=((U)>>6)&1,b_=(U)>>7; const bf16*Qw_=P+OFF_QC+((size_t)(b_*4+kv_*2+g)*SEQ+128L*n_+qs+r32)*64+hi*8; _Pragma("unroll") for(int d0=0;d0<4;++d0)QO[d0]=*(const MB_GAS bf16x8*)(Qw_+d0*16); }while(0)
  bf16x8 qr[4],qn[4]; int u=vcu,buf=0;
  if(u<NU){ SWA_DMA(u,0); SWA_Q(u,qr); }
  #pragma unroll 1
  for(;u<NU;u+=G){
    WAIT_BAR(0);
    if(u+G<NU){ SWA_DMA(u+G,buf^1); }
    const int n=u&63,kv=(u>>6)&1,b=u>>7,hq=kv*2+g;
    const float slope=__builtin_amdgcn_exp2f(-(float)(1+hq));
    const unsigned w_A=cvtpk_s(slope*Lh,slope*Ll)&hm, w_32A=cvtpk_s(32.f*slope*Lh,32.f*slope*Ll)&hm;
    const int qq=128+qs+r32;
    const float crow_x=-(slope*LOG2E)*(float)qq, crow_c=bfround(crow_x), crow_d=crow_c-crow_x;
    u32x4 ka,qa0,qa1;
    { const unsigned jw=cvtpk_s((float)r32,(float)r32)&hm; ka[0]=jw; ka[1]=0u; ka[2]=0x3f803f80u&hm; ka[3]=0x3f803f80u&hm;
      const unsigned wm=cvtpk_s(0.f,crow_c)&hm; qa0[0]=w_A;qa0[1]=w_A;qa0[2]=wm;qa0[3]=0u; qa1[0]=w_A;qa1[1]=w_A;qa1[2]=wm;qa1[3]=w_32A; }
    const size_t hrow=(size_t)(b*4+hq)*SEQ+128L*n+qs;
    u32x4 gt[4];
    #pragma unroll
    for(int k=0;k<4;++k) gt[k]=*(const MB_GAS u32x4*)(P+OFF_GC+(hrow+8*k+(lane>>3))*64+(lane&7)*8);
    f32x16 o[2]; o[0]=f32x16{}; o[1]=f32x16{}; float l=0.f;
    const lds_cptr kpb=kp0+buf*65536, vpb=vp0+buf*65536;
    if(n==0){ if(tl) chunk_attn<2,2>(o,l,qr,ka,qa0,qa1,hm,0.f,kpb,vpb,2,r32,hi,qq); else chunk_attn<1,2>(o,l,qr,ka,qa0,qa1,hm,0.f,kpb,vpb,2,r32,hi,qq); }
    else chunk_attn<3,2>(o,l,qr,ka,qa0,qa1,hm,0.f,kpb,vpb,tl,r32,hi,qq);
    if(u+G<NU){ SWA_Q(u+G,qn); }
    { auto rr=__builtin_amdgcn_permlane32_swap(__float_as_uint(l),__float_as_uint(l),false,false); l=__uint_as_float(rr[0])+__uint_as_float(rr[1]); }
    l+=__builtin_amdgcn_exp2f(*(const MB_GAS float*)(sinks+hq)*LOG2E+crow_d);
    if(hi==0)wsf[32+r32]=__builtin_amdgcn_rcpf(l); asm volatile("s_waitcnt lgkmcnt(0)":::"memory");
    const size_t yrow=(size_t)b*SEQ+128L*n+qs;
    #pragma unroll
    for(int k=0;k<4;++k){ const u32x4 v=stage8(o,wsf,stg,k,lane,r32,hi); const u32x4 gg=gt[k]; u32x4 w;
      #pragma unroll
      for(int e=0;e<4;++e) w[e]=cvtpk_s(__uint_as_float(v[e]<<16)*__uint_as_float(gg[e]<<16),__uint_as_float(v[e]&0xffff0000u)*__uint_as_float(gg[e]&0xffff0000u));
      *(MB_GAS u32x4*)(Y+(yrow+8*k+(lane>>3))*YPITCH+512+hq*D+(lane&7)*8)=w; }
    #pragma unroll
    for(int d0=0;d0<4;++d0)qr[d0]=qn[d0];
    buf^=1;
  }
  #undef SWA_DMA
  #undef SWA_Q
  __builtin_amdgcn_s_setprio(0);
  asm volatile("s_waitcnt vmcnt(0) lgkmcnt(0)\n\ts_barrier":::"memory");
}
constexpr int SP_LDS_C=65536, SP_LDS_WSF=65536+12288, SP_LDS_DST=SP_LDS_WSF+NW*256, SP_LDS_STG=SP_LDS_DST+NW*128, SP_LDS_BYTES=SP_LDS_STG+NW*4096;
typedef __attribute__((address_space(3))) unsigned lds_u32;
__device__ __forceinline__ void select_phase(char*scr,const bf16*P,const float*kmean,unsigned*cnt,unsigned short*lst,int vcu,int G){
  int tid_=threadIdx.x; asm volatile("":"+v"(tid_));
  const int tid=tid_,lane=tid&63,r32=lane&31,hi=lane>>5; const int wid=__builtin_amdgcn_readfirstlane(tid>>6);
  lds_u32*ldscnt=(lds_u32*)(scr+GS_C);
  const int qrel=wid*QBLK+r32;
  #pragma unroll 1
  for(int u=vcu;u<32*NQB;u+=G){
    const int bh=u>>5,qb=u&31;
    if(tid<32)ldscnt[tid]=0u;
    bf16x8 qr[4];
    #pragma unroll
    for(int d0=0;d0<4;++d0)qr[d0]=*(const MB_GAS bf16x8*)(&P[OFF_QA+((size_t)bh*SEQ+qb*QB+qrel)*64+d0*16+hi*8]);
    f32x16 bsc=f32x16{};
    const float*kmr=kmean+(size_t)bh*32*64+r32*64+hi*8;
    #pragma unroll
    for(int d0=0;d0<4;++d0){ const f32x4 a=*(const MB_GAS f32x4*)(kmr+d0*16), c=*(const MB_GAS f32x4*)(kmr+d0*16+4);
      const float x[8]={a[0],a[1],a[2],a[3],c[0],c[1],c[2],c[3]}; u32x4 hw,lw;
      #pragma unroll
      for(int i=0;i<4;++i){ const unsigned ph=cvtpk_s(x[2*i],x[2*i+1]); const float h0=__uint_as_float(ph<<16),h1=__uint_as_float(ph&0xffff0000u); hw[i]=ph; lw[i]=cvtpk_s(x[2*i]-h0,x[2*i+1]-h1); }
      bsc=MFMA32(__builtin_bit_cast(bf16x8,hw),qr[d0],bsc); bsc=MFMA32(__builtin_bit_cast(bf16x8,lw),qr[d0],bsc); }
    #pragma unroll
    for(int r=0;r<16;++r) if(crow(r,hi)>=qb) bsc[r]=-INFINITY;
    int wn[3]; bool wok[3];
    #pragma unroll
    for(int rd=0;rd<3;++rd){
      float bv=bsc[0]; int bi=crow(0,hi);
      #pragma unroll
      for(int r=1;r<16;++r){ if(bsc[r]>bv){bv=bsc[r];bi=crow(r,hi);} }
      auto sv=__builtin_amdgcn_permlane32_swap(__float_as_uint(bv),__float_as_uint(bv),false,false);
      auto si=__builtin_amdgcn_permlane32_swap((unsigned)bi,(unsigned)bi,false,false);
      const float v0=__uint_as_float(sv[0]),v1=__uint_as_float(sv[1]); const int i0=(int)si[0],i1=(int)si[1];
      const bool first=(v0>v1)||(v0==v1&&i0<i1); const float wv=first?v0:v1; wn[rd]=first?i0:i1; wok[rd]=wv>-INFINITY;
      #pragma unroll
      for(int r=0;r<16;++r) if(crow(r,hi)==wn[rd]) bsc[r]=-INFINITY;
    }
    asm volatile("s_waitcnt lgkmcnt(0)\n\ts_barrier":::"memory");
    #pragma unroll
    for(int rd=0;rd<3;++rd) if(wok[rd]&&hi==0){ const unsigned pos=__hip_atomic_fetch_add(ldscnt+wn[rd],1u,__ATOMIC_RELAXED,__HIP_MEMORY_SCOPE_WORKGROUP);
        *(MB_GAS unsigned short*)(lst+(((size_t)bh*32+wn[rd])*32+qb)*256+pos)=(unsigned short)((rd<<8)|qrel); }
    asm volatile("s_waitcnt lgkmcnt(0)\n\ts_barrier":::"memory");
    if(tid<32)*(MB_GAS unsigned*)(cnt+((size_t)bh*32+tid)*32+qb)=ldscnt[tid];
  }
  asm volatile("s_waitcnt lgkmcnt(0)\n\ts_barrier":::"memory");
}
__device__ __forceinline__ void own_merge_phase(char*shm,char*scr,const bf16*P,const bf16*partO,const float*partL,bf16*Y,int vcu,int G){
  int tid_=threadIdx.x; asm volatile("":"+v"(tid_));
  const int tid=tid_,lane=tid&63,r32=lane&31,hi=lane>>5; const int wid=__builtin_amdgcn_readfirstlane(tid>>6);
  if(wid>=4)__builtin_amdgcn_s_setprio(1);
  const unsigned lds0=(unsigned)(uintptr_t)shm;
  MB_LAS float*wsf=(MB_LAS float*)(scr+GS_WSF)+wid*64; MB_LAS bf16*stg=(MB_LAS bf16*)(scr+GS_STG)+wid*512;
  const lds_cptr shm3=(lds_cptr)shm; const lds_cptr vp0=shm3+4*SLOTB+((lane>>4)&1)*32+(lane&3)*8+(4*hi+((lane&15)>>2))*64; const lds_cptr kp0=shm3+hi*1024+r32*16;
  const unsigned kdst=lds0+wid*1024, vdst=lds0+4*SLOTB+wid*1024;
  const unsigned hm=hi?0u:0xffffffffu; const float Lh=bfround(LOG2E),Ll=bfround(LOG2E-Lh);
  const int qrel=wid*QBLK+r32, NU=32*NQB;
  #define OWN_DMA(U,BUF) do{ const int bh_=(U)>>5,qb_=(U)&31; const bf16*ks_=P+OFF_KA+((size_t)bh_*SEQ+qb_*QB+lane)*64+wid*8; const bf16*vs_=P+OFF_VA+((size_t)bh_*SEQ+qb_*QB+16*(wid&3)+(lane>>2))*64+(wid>>2)*32+(lane&3)*8; \
      _Pragma("unroll") for(int t=0;t<4;++t){ glds16(ks_+(long)t*KVBLK*64,(unsigned)__builtin_amdgcn_readfirstlane(kdst+(BUF)*65536+t*SLOTB)); glds16(vs_+(long)t*KVBLK*64,(unsigned)__builtin_amdgcn_readfirstlane(vdst+(BUF)*65536+t*SLOTB)); } }while(0)
  #define OWN_Q(U,QO) do{ const int bh_=(U)>>5,qb_=(U)&31; const bf16*Qw_=P+OFF_QA+((size_t)bh_*SEQ+qb_*QB+qrel)*64+hi*8; _Pragma("unroll") for(int d0=0;d0<4;++d0)QO[d0]=*(const MB_GAS bf16x8*)(Qw_+d0*16); }while(0)
  bf16x8 qr[4],qn[4]; int u=vcu,buf=0;
  if(u<NU){ OWN_DMA(u,0); OWN_Q(u,qr); }
  #pragma unroll 1
  for(;u<NU;u+=G){
    WAIT_BAR(0);
    if(u+G<NU){ OWN_DMA(u+G,buf^1); }
    const int bh=u>>5,qb=u&31,h=bh&3,b=bh>>2,nsel=qb<3?qb:3;
    const float slope=__builtin_amdgcn_exp2f(-(float)(5+h));
    const unsigned w_A=cvtpk_s(slope*Lh,slope*Ll)&hm, w_32A=cvtpk_s(32.f*slope*Lh,32.f*slope*Ll)&hm;
    const float crow_x=-(slope*LOG2E)*(float)qrel, crow_c=bfround(crow_x), crow_d=crow_c-crow_x;
    u32x4 ka,qa0,qa1;
    { const unsigned jw=cvtpk_s((float)r32,(float)r32)&hm; ka[0]=jw; ka[1]=0u; ka[2]=0x3f803f80u&hm; ka[3]=0x3f803f80u&hm;
      const unsigned wm=cvtpk_s(0.f,crow_c)&hm; qa0[0]=w_A;qa0[1]=w_A;qa0[2]=wm;qa0[3]=0u; qa1[0]=w_A;qa1[1]=w_A;qa1[2]=wm;qa1[3]=w_32A; }
    f32x16 o[2]; o[0]=f32x16{}; o[1]=f32x16{}; float l=0.f;
    const lds_cptr kpb=kp0+buf*65536, vpb=vp0+buf*65536; const int tlast=wid>>1, qd=qrel-64*tlast;
    if(tlast==0) chunk_attn<1,1>(o,l,qr,ka,qa0,qa1,hm,0.f,kpb,vpb,0,r32,hi,qd); else if(tlast==1) chunk_attn<2,1>(o,l,qr,ka,qa0,qa1,hm,0.f,kpb,vpb,0,r32,hi,qd);
    else if(tlast==2) chunk_attn<3,1>(o,l,qr,ka,qa0,qa1,hm,0.f,kpb,vpb,0,r32,hi,qd); else chunk_attn<4,1>(o,l,qr,ka,qa0,qa1,hm,0.f,kpb,vpb,0,r32,hi,qd);
    { auto rr=__builtin_amdgcn_permlane32_swap(__float_as_uint(l),__float_as_uint(l),false,false); l=__uint_as_float(rr[0])+__uint_as_float(rr[1]); }
    if(u+G<NU){ OWN_Q(u+G,qn); }
    const float sh=__builtin_amdgcn_exp2f(-crow_d);
    if(hi==0){ wsf[r32]=l*sh; wsf[32+r32]=sh; } asm volatile("s_waitcnt lgkmcnt(0)":::"memory");
    const size_t q0row=(size_t)bh*SEQ+qb*QB+wid*QBLK;
    f32x4 lv4[4]; u32x4 pp0[4],pp1[4],pp2[4],gg4[4];
    #pragma unroll
    for(int k=0;k<4;++k){ const int row=8*k+(lane>>3),ch=lane&7; const bf16*po=partO+(q0row+row)*256+ch*8;
      lv4[k]=*(const MB_GAS f32x4*)(partL+(q0row+row)*4);
      pp0[k]=(u32x4){0u,0u,0u,0u}; pp1[k]=pp0[k]; pp2[k]=pp0[k];
      if(nsel>0)pp0[k]=*(const MB_GAS u32x4*)(po); if(nsel>1)pp1[k]=*(const MB_GAS u32x4*)(po+64); if(nsel>2)pp2[k]=*(const MB_GAS u32x4*)(po+128);
      gg4[k]=*(const MB_GAS u32x4*)(P+OFF_GA+(q0row+row)*64+ch*8); }
    #pragma unroll
    for(int k=0;k<4;++k){ const int row=8*k+(lane>>3),ch=lane&7;
      const f32x4 lv=lv4[k]; const u32x4 p0=pp0[k],p1=pp1[k],p2=pp2[k],gg=gg4[k];
      const u32x4 v=stage8(o,wsf,stg,k,lane,r32,hi);
      const float l0=nsel>0?lv[0]:0.f,l1=nsel>1?lv[1]:0.f,l2=nsel>2?lv[2]:0.f; const float iw=__builtin_amdgcn_rcpf(wsf[row]+l0+l1+l2); u32x4 w;
      #pragma unroll
      for(int e=0;e<4;++e){ const float a0=__uint_as_float(v[e]<<16)+l0*__uint_as_float(p0[e]<<16)+l1*__uint_as_float(p1[e]<<16)+l2*__uint_as_float(p2[e]<<16);
        const float a1=__uint_as_float(v[e]&0xffff0000u)+l0*__uint_as_float(p0[e]&0xffff0000u)+l1*__uint_as_float(p1[e]&0xffff0000u)+l2*__uint_as_float(p2[e]&0xffff0000u);
        w[e]=cvtpk_s(a0*iw*__uint_as_float(gg[e]<<16),a1*iw*__uint_as_float(gg[e]&0xffff0000u)); }
      *(MB_GAS u32x4*)(Y+((size_t)b*SEQ+qb*QB+wid*QBLK+row)*YPITCH+h*D+ch*8)=w; }
    #pragma unroll
    for(int d0=0;d0<4;++d0)qr[d0]=qn[d0];
    buf^=1;
  }
  #undef OWN_DMA
  #undef OWN_Q
  __builtin_amdgcn_s_setprio(0);
  asm volatile("s_waitcnt vmcnt(0) lgkmcnt(0)\n\ts_barrier":::"memory");
}
__device__ __forceinline__ void sp_store8(const f32x16*o,float linv_src,bf16*base,const MB_LAS int*dstl,MB_LAS float*wsf,MB_LAS bf16*stg,int lane,int r32,int hi){
  if(hi==0)wsf[32+r32]=linv_src; asm volatile("s_waitcnt lgkmcnt(0)":::"memory");
  #pragma unroll
  for(int k=0;k<4;++k){
    #pragma unroll
    for(int rr=0;rr<4;++rr){ const int r=4*k+rr, lrow=rr+4*hi; const float ri=wsf[32+crow(r,hi)];
      #pragma unroll
      for(int d0=0;d0<2;++d0)stg[lrow*64+d0*32+r32]=(bf16)(cvtpk_s(o[d0][r]*ri,0.f)&0xffffu);}
    asm volatile("s_waitcnt lgkmcnt(0)":::"memory");
    { const int lrow=lane>>3,ch=lane&7; const long d=dstl[8*k+lrow]; const u32x4 v=*(const MB_LAS u32x4*)(stg+lrow*64+ch*8); if(d>=0) *(MB_GAS u32x4*)(base+d+ch*8)=v; }
    asm volatile("s_waitcnt lgkmcnt(0)":::"memory");
  }
}
__device__ __forceinline__ void gather_phase(char*shm,char*scr,const bf16*P,const unsigned*cnt,const unsigned short*lst,bf16*partO,float*partL,int vcu){
  int tid_=threadIdx.x; asm volatile("":"+v"(tid_));
  const int tid=tid_,lane=tid&63,r32=lane&31,hi=lane>>5; const int wid=__builtin_amdgcn_readfirstlane(tid>>6);
  if(wid>=4)__builtin_amdgcn_s_setprio(1);
  const int bh=vcu>>3,sv=vcu&7,b=bh>>2,h=bh&3; const long rowbase=(long)b*SEQ;
  const unsigned lds0=(unsigned)(uintptr_t)shm;
  volatile lds_u32*C=(volatile lds_u32*)(scr+GS_C); volatile lds_u32*Tj=(volatile lds_u32*)(scr+GS_TJ); volatile lds_u32*pre=(volatile lds_u32*)(scr+GS_PRE); volatile lds_u32*QP=(volatile lds_u32*)(scr+GS_QP); volatile lds_u32*RNG=(volatile lds_u32*)(scr+GS_RNG);
  MB_LAS float*wsf=(MB_LAS float*)(scr+GS_WSF)+wid*64; MB_LAS int*dstl=(MB_LAS int*)(scr+GS_DST)+wid*32; MB_LAS bf16*stg=(MB_LAS bf16*)(scr+GS_STG)+wid*512;
  if(tid<32){ unsigned cj[32];
    #pragma unroll
    for(int q4=0;q4<8;++q4){ const u32x4 t4=*(const MB_GAS u32x4*)(cnt+(size_t)bh*1024+tid*32+4*q4); cj[4*q4]=t4[0]; cj[4*q4+1]=t4[1]; cj[4*q4+2]=t4[2]; cj[4*q4+3]=t4[3]; }
    unsigned run=0u;
    #pragma unroll
    for(int q=0;q<32;++q){ QP[tid*33+q]=run; run+=(q>tid)?cj[q]:0u; }
    QP[tid*33+32]=run; Tj[tid]=run;
    const unsigned n=(run+255u)>>8, wgt=n?2u*n+1u:0u; unsigned pn=n, pw=wgt;
    #pragma unroll
    for(int o=1;o<32;o<<=1){ const unsigned a=__shfl_up(pn,o,32), bq=__shfl_up(pw,o,32); if(tid>=o){ pn+=a; pw+=bq; } }
    const unsigned ntot=__shfl(pn,31,32), wt=__shfl(pw,31,32);
    pre[tid]=pn-n; if(tid==31)pre[32]=ntot;
    const unsigned p2=pw-wgt;
    #pragma unroll
    for(int k=0;k<2;++k){ const unsigned target=wt*(unsigned)(sv+k)/8u; unsigned cc=0u; if(n&&target>p2+1u){ cc=(target-p2)>>1; if(cc>n)cc=n; }
      #pragma unroll
      for(int o=16;o>=1;o>>=1) cc+=__shfl_xor(cc,o,32);
      if(tid==0)RNG[k]=cc; } }
  asm volatile("s_waitcnt vmcnt(0) lgkmcnt(0)\n\ts_barrier":::"memory");
  const int i0=(int)RNG[0], i1=(int)RNG[1];
  const unsigned hm=hi?0u:0xffffffffu;
  const float slope=__builtin_amdgcn_exp2f(-(float)(5+h)),sl2=slope*LOG2E;
  const float Lh=bfround(LOG2E),Ll=bfround(LOG2E-Lh);
  const unsigned w_A=cvtpk_s(slope*Lh,slope*Ll)&hm, w_32A=cvtpk_s(32.f*slope*Lh,32.f*slope*Ll)&hm;
  u32x4 ka,qa0,qa1;
  { const unsigned jw=cvtpk_s((float)r32,(float)r32)&hm; ka[0]=jw; ka[1]=0u; ka[2]=0x3f803f80u&hm; ka[3]=0x3f803f80u&hm;
    qa0[0]=w_A;qa0[1]=w_A;qa0[2]=0u;qa0[3]=0u; qa1[0]=w_A;qa1[1]=w_A;qa1[2]=0u;qa1[3]=w_32A; }
  const lds_cptr shm3=(lds_cptr)shm; const lds_cptr vp0=shm3+4*SLOTB+((lane>>4)&1)*32+(lane&3)*8+(4*hi+((lane&15)>>2))*64; const lds_cptr kp0=shm3+hi*1024+r32*16;
  const unsigned kdst=lds0+wid*1024, vdst=lds0+4*SLOTB+wid*1024;
  #define BLK_DMA(J,BUF) do{ const bf16*ks_=P+OFF_KA+((size_t)bh*SEQ+256L*(J)+lane)*64+wid*8; const bf16*vs_=P+OFF_VA+((size_t)bh*SEQ+256L*(J)+16*(wid&3)+(lane>>2))*64+(wid>>2)*32+(lane&3)*8; \
      _Pragma("unroll") for(int t=0;t<4;++t){ glds16(ks_+(long)t*KVBLK*64,(unsigned)__builtin_amdgcn_readfirstlane(kdst+(BUF)*65536+t*SLOTB)); glds16(vs_+(long)t*KVBLK*64,(unsigned)__builtin_amdgcn_readfirstlane(vdst+(BUF)*65536+t*SLOTB)); } }while(0)
  int jn=0;
  #define LOOKUP(IT,JO,EO,VO) do{ const int it_=(IT); JO=-1; EO=0u; VO=false; if(it_<i1){ while((int)pre[jn+1]<=it_)++jn; JO=jn; const int c_=it_-(int)pre[jn]; const int T_=(int)Tj[jn]; \
      const int g_=256*c_+wid*QBLK+r32; VO=g_<T_; const int gg_=VO?g_:T_-1; int qb_=0; _Pragma("unroll") for(int st=16;st>=1;st>>=1) if((int)QP[jn*33+qb_+st]<=gg_) qb_+=st; \
      const int idx_=gg_-(int)QP[jn*33+qb_]; EO=(unsigned)qb_<<16|(unsigned)*(const MB_GAS unsigned short*)(lst+(((size_t)bh*32+jn)*32+qb_)*256+idx_); } }while(0)
  #define QLOAD(EI,QO,TQO) do{ TQO=256*(int)((EI)>>16)+(int)((EI)&255u); const bf16*Qp_=P+OFF_QA+((size_t)bh*SEQ+TQO)*64+hi*8; _Pragma("unroll") for(int d0=0;d0<4;++d0)QO[d0]=*(const MB_GAS bf16x8*)(Qp_+d0*16); }while(0)
  int j0_,j1_,j2_; unsigned e0_,e1_,e2_; bool v0_,v1_,v2_; bf16x8 qr[4],qn[4]; int tq=0,tqn=0;
  LOOKUP(i0,j0_,e0_,v0_); LOOKUP(i0+1,j1_,e1_,v1_);
  if(i0<i1){ QLOAD(e0_,qr,tq); BLK_DMA(j0_,0); }
  int curj=-1,buf=1,pfj=(i0<i1)?j0_:-1;
  #pragma unroll 1
  for(int it=i0;it<i1;++it){
    const int j=j0_; const bool valid=v0_; const int slot=(int)((e0_>>8)&255u);
    if(j!=curj){ buf^=1; WAIT_BAR(0); curj=j; }
    LOOKUP(it+2,j2_,e2_,v2_);
    if(it+1<i1) QLOAD(e1_,qn,tqn);
    if(j1_>=0&&j1_!=j&&pfj!=j1_){
      asm volatile("s_waitcnt lgkmcnt(0)\n\ts_barrier":::"memory");
      BLK_DMA(j1_,buf^1); pfj=j1_; }
    const lds_cptr kpb=kp0+buf*65536, vpb=vp0+buf*65536;
    f32x16 o[2]; o[0]=f32x16{}; o[1]=f32x16{}; float l=0.f;
    chunk_attn<4,0>(o,l,qr,ka,qa0,qa1,hm,-255.f,kpb,vpb,0,r32,hi,0);
    { auto rr=__builtin_amdgcn_permlane32_swap(__float_as_uint(l),__float_as_uint(l),false,false); l=__uint_as_float(rr[0])+__uint_as_float(rr[1]); }
    const size_t prow=((size_t)bh*SEQ+tq)*4+slot;
    if(hi==0){ dstl[r32]=valid?(int)(prow*64):-1; if(valid) *(MB_GAS float*)(partL+prow)=l*__builtin_amdgcn_exp2f(sl2*(float)(256*j+255-tq)); }
    sp_store8(o,__builtin_amdgcn_rcpf(l),partO,dstl,wsf,stg,lane,r32,hi);
    j0_=j1_;e0_=e1_;v0_=v1_; j1_=j2_;e1_=e2_;v1_=v2_; tq=tqn;
    #pragma unroll
    for(int d0=0;d0<4;++d0)qr[d0]=qn[d0];
  }
  #undef LOOKUP
  #undef QLOAD
  #undef BLK_DMA
  __builtin_amdgcn_s_setprio(0);
  asm volatile("s_waitcnt vmcnt(0) lgkmcnt(0)\n\ts_barrier":::"memory");
}
#undef SBAR
#undef WAIT_BAR
#undef MFMA32
#undef MX3
}
constexpr int NWAVES = 8;
#ifndef IN_ONE_CALL
#define IN_ONE_CALL 0
#endif
#ifndef STAGGER_IN
#define STAGGER_IN 0
#endif
#ifndef STAGGER_OUT
#define STAGGER_OUT 0
#endif
#ifndef MK_N_LAUNCHES
#define MK_N_LAUNCHES 1
#endif
constexpr int N_LAUNCHES = MK_N_LAUNCHES;
constexpr int N_PHASES = 11;
static_assert(WS_WIN + 2 * (size_t)NPROJ * DM * 2 <= WS_WOUT && WS_WOUT + 2 * (size_t)DM * DM * 2 <= WS_XB && WS_XB + (size_t)M * DM * 2 <= WS_Y && WS_Y + (size_t)M * DM * 2 <= WS_PROJ && WS_PROJ + (size_t)M * NPROJ * 2 <= WS_END, "d_ws map");
constexpr int CW_TMO = 0, CW_BAR = 4096;
static_assert((CW_BAR + XCD_BAR_WORDS) * 4 <= (int)WS_KMEAN && WS_KMEAN + 2 * 65536 * 4 <= WS_SSQ2 && WS_SSQ2 + (size_t)M * 4 <= CTL_ZERO_BYTES, "ctl map");
constexpr int RING_OFF = 0, RING_BYTES = 131072;
constexpr int LDSCTL_OFF = RING_BYTES, MISC_OFF = LDSCTL_OFF + 320, AUX_OFF = RING_BYTES + 4096;
constexpr int SCR_OFF = AUX_OFF + 4096;
constexpr int LDS_BYTES = 163840;
static_assert(SCR_OFF + moba_body::GS_BYTES <= LDS_BYTES, "LDS map");

struct Frame {
    LAS unsigned char* lds; volatile LAS unsigned* MISC; gu32* ctl;
    int tid, lane, wave, vcu, G;
    const float *x, *norm_g, *w_in, *w_out, *a_qn, *a_kn, *pool_w, *pool_scale, *c_qn, *c_kn, *c_sinks, *conv_w;
    float* out;
    bf16 *Win_t, *Wout_t, *XB, *Y, *PROJ; float *kmean, *ssq1, *ssq2;
    unsigned* cnt; unsigned short* lst; bf16* partO; float* partL; float *Hu, *Hg;
    __device__ __forceinline__ void refresh() { int t = threadIdx.x; asm volatile("" : "+v"(t)); tid = t; lane = t & 63; wave = __builtin_amdgcn_readfirstlane(t >> 6); int v = vcu; asm volatile("" : "+s"(v)); vcu = v; }
};
__device__ __forceinline__ float bf2f(bf16 b) { return __uint_as_float((unsigned)b << 16); }
__device__ __forceinline__ float wave_sum(float v) {
#pragma unroll
    for (int o = 1; o < 64; o <<= 1) v += __shfl_xor(v, o);
    return v;
}
__device__ __forceinline__ float wave_max(float v) {
#pragma unroll
    for (int o = 1; o < 64; o <<= 1) v = fmaxf(v, __shfl_xor(v, o));
    return v;
}
__device__ __forceinline__ float rdl(float v, int l) { return __uint_as_float((unsigned)__builtin_amdgcn_readlane((int)__float_as_uint(v), l)); }
__device__ __forceinline__ void p0_store_item(LAS float* scr, bf16* WT, int n0, bool mapped, int k0, int lane) {
    LDS_WAIT(); asm volatile("" ::: "memory");
    const int c = lane & 7;
#pragma unroll
    for (int j = 0; j < 4; ++j) { const int n = (lane >> 3) + 8 * j; const LAS float* s = scr + (8 * c) * 33 + n;
        v4u o; o.x = pk2(s[0 * 33], s[1 * 33]); o.y = pk2(s[2 * 33], s[3 * 33]); o.z = pk2(s[4 * 33], s[5 * 33]); o.w = pk2(s[6 * 33], s[7 * 33]);
        const int prow = mapped ? phys_row(n0 + n) : n0 + n;
        *(GAS v4u*)(WT + (size_t)prow * 1024 + k0 + 8 * c) = o; }
    LDS_WAIT(); asm volatile("" ::: "memory");
}
__device__ __forceinline__ void p0_prologue(Frame& F) {
    F.refresh();
    LAS float* scr = (LAS float*)(F.lds + RING_OFF + F.wave * 16384);
    const int gw = F.vcu * NWAVES + F.wave, NGW = F.G * NWAVES, lane = F.lane;
    constexpr int I_IN = 16 * 104, I_OUT = 16 * 32, I_L = I_IN + I_OUT;
    for (int it = gw; it < NLAYER * I_L; it += NGW) {
        const int l = it / I_L; int r = it % I_L;
        if (r < I_IN) {
            const int kb = r / 104, nb = r % 104, k0 = 64 * kb, n0 = 32 * nb;
            const float* W = F.w_in + (size_t)l * 1024 * NPROJ; const float* gn = F.norm_g + l * 1024;
            if (n0 >= C_BU && n0 < C_BG) {
                const int g = (n0 - C_BU) >> 6, np0 = (n0 - C_BU) & 63; const float* pw = F.pool_w + ((size_t)l * 4 + g) * 64 * 64 + np0; const float* ps = F.pool_scale + l * 256 + (n0 - C_BU);
                const GAS f32x4* wrow = (const GAS f32x4*)(W + (size_t)(k0 + lane) * NPROJ + C_BU + 64 * g); float wv[64], accp[32];
#pragma unroll
                for (int q = 0; q < 16; ++q) { const f32x4 t4 = wrow[q]; wv[4 * q] = t4.x; wv[4 * q + 1] = t4.y; wv[4 * q + 2] = t4.z; wv[4 * q + 3] = t4.w; }
#pragma unroll
                for (int n = 0; n < 32; ++n) accp[n] = 0.f;
#pragma unroll
                for (int cc = 0; cc < 64; ++cc) {
#pragma unroll
                    for (int n = 0; n < 32; ++n) accp[n] += wv[cc] * pw[cc * 64 + n]; }
                const float gk = gn[k0 + lane];
#pragma unroll
                for (int n = 0; n < 32; ++n) scr[lane * 33 + n] = accp[n] * ps[n] * gk;
            } else {
#pragma unroll 8
                for (int i = 0; i < 32; ++i) { const int kk = 2 * i + (lane >> 5); scr[kk * 33 + (lane & 31)] = W[(size_t)(k0 + kk) * NPROJ + n0 + (lane & 31)] * gn[k0 + kk]; }
            }
            p0_store_item(scr, F.Win_t + (size_t)l * NPROJ * 1024, n0, true, k0, lane);
        } else {
            r -= I_IN; const int kb = r / 32, nb = r % 32, k0 = 64 * kb, n0 = 32 * nb; const float* W = F.w_out + (size_t)l * 1024 * 1024;
#pragma unroll 8
            for (int i = 0; i < 32; ++i) { const int kk = 2 * i + (lane >> 5); scr[kk * 33 + (lane & 31)] = W[(size_t)(k0 + kk) * 1024 + n0 + (lane & 31)]; }
            p0_store_item(scr, F.Wout_t + (size_t)l * 1024 * 1024, n0, false, k0, lane);
        }
    }
    { GAS f32x4* z0 = (GAS f32x4*)F.kmean; GAS f32x4* z1 = (GAS f32x4*)F.ssq2; const int gtid = F.vcu * (NWAVES * 64) + F.tid, ngt = F.G * NWAVES * 64;
      for (int i = gtid; i < 2 * 65536 / 4; i += ngt) z0[i] = (f32x4){0.f, 0.f, 0.f, 0.f};
      for (int i = gtid; i < M / 4; i += ngt) z1[i] = (f32x4){0.f, 0.f, 0.f, 0.f}; }
    for (int m0 = 4 * gw; m0 < M; m0 += 4 * NGW) {
        f32x4 v[4][4]; float s[4];
#pragma unroll
        for (int q = 0; q < 4; ++q) { const GAS f32x4* xr = (const GAS f32x4*)(F.x + (size_t)(m0 + q) * DM) + lane;
#pragma unroll
            for (int j = 0; j < 4; ++j) v[q][j] = __builtin_nontemporal_load(xr + 64 * j); }
#pragma unroll
        for (int q = 0; q < 4; ++q) { s[q] = 0.f;
#pragma unroll
            for (int j = 0; j < 4; ++j) s[q] += (v[q][j].x * v[q][j].x + v[q][j].y * v[q][j].y) + (v[q][j].z * v[q][j].z + v[q][j].w * v[q][j].w); }
#pragma unroll
        for (int o = 1; o < 64; o <<= 1) {
#pragma unroll
            for (int q = 0; q < 4; ++q) s[q] += __shfl_xor(s[q], o); }
        if (lane < 4) F.ssq1[m0 + lane] = lane == 0 ? s[0] : lane == 1 ? s[1] : lane == 2 ? s[2] : s[3];
#pragma unroll
        for (int q = 0; q < 4; ++q) { GAS unsigned long long* o8 = (GAS unsigned long long*)(F.XB + (size_t)(m0 + q) * DM) + lane;
#pragma unroll
            for (int j = 0; j < 4; ++j) o8[64 * j] = (unsigned long long)pk2(v[q][j].x, v[q][j].y) | ((unsigned long long)pk2(v[q][j].z, v[q][j].w) << 32); }
    }
}
__device__ __forceinline__ void convfix_phase(Frame& F, int layer) {
    F.refresh();
    const int gt = F.vcu * (NWAVES * 64) + F.tid, NGT = F.G * NWAVES * 64; const float* cw = F.conv_w + (size_t)layer * 768;
    for (int it = gt; it < 256 * 2 * 256; it += NGT) { const int c = it & 255, r = (it >> 8) & 1, pm = it >> 9;
        if ((pm & 31) == 0) continue;
        const float u1 = F.Hu[((size_t)(pm - 1) * 2 + 1) * 256 + c], u2 = F.Hu[((size_t)(pm - 1) * 2 + 0) * 256 + c], g = F.Hg[((size_t)pm * 2 + r) * 256 + c];
        const float fix = g * (r == 0 ? cw[c] * u2 + cw[256 + c] * u1 : cw[c] * u1);
        bf16* y = F.Y + (size_t)(pm * 256 + r) * DM + 768 + c; *y = (bf16)f2bf(bf2f(*y) + fix); }
}
__device__ __forceinline__ void poolfix_phase(Frame& F, int layer) {
    F.refresh();
    const float* Hpu = (const float*)((const char*)F.PROJ - WS_PROJ + WS_PHALO); const float* Hpg = Hpu + 256 * 16 * 256;
    const int gt = F.vcu * (NWAVES * 64) + F.tid, NGT = F.G * NWAVES * 64;
    for (int it = gt; it < 256 * 256; it += NGT) { const int c = it & 255, pm = it >> 8;
        if ((pm & 31) == 0) continue;
        const int w = 2 << (c >> 6); float up[15], gq[15], yv[15];
#pragma unroll
        for (int d = 1; d <= 15; ++d) up[d - 1] = d < w ? Hpu[((size_t)(pm - 1) * 16 + 16 - d) * 256 + c] : 0.f;
#pragma unroll
        for (int r = 0; r < 15; ++r) { const bool on = r < w - 1; gq[r] = on ? Hpg[((size_t)pm * 16 + r) * 256 + c] : 0.f; yv[r] = on ? bf2f(F.Y[(size_t)(pm * 256 + r) * DM + 256 + c]) : 0.f; }
        float s = 0.f;
#pragma unroll
        for (int d = 0; d < 15; ++d) s += up[d];
        const float iw = 1.0f / (float)w;
#pragma unroll
        for (int r = 0; r < 15; ++r) { if (r < w - 1) { F.Y[(size_t)(pm * 256 + r) * DM + 256 + c] = (bf16)f2bf(yv[r] + s * iw * gq[r]); s -= up[w - 2 - r]; } }
    }
}
struct Args { const float* in[12]; float* out; unsigned char* ws; int ph_lo, ph_hi, li, pad; };
__global__ void __launch_bounds__(NWAVES * 64, 2) hybrid_fwd(Args args) {
    extern __shared__ __attribute__((aligned(16))) unsigned char lds[];
    Frame F;
    F.lds = (LAS unsigned char*)lds; F.MISC = (volatile LAS unsigned*)(F.lds + MISC_OFF);
    F.tid = threadIdx.x; F.lane = F.tid & 63; F.wave = __builtin_amdgcn_readfirstlane(F.tid >> 6);
    F.G = gridDim.x; { const int bx = blockIdx.x; F.vcu = (F.G % 8 == 0) ? (bx % 8) * (F.G / 8) + bx / 8 : bx; }
    unsigned char* ws = args.ws;
    F.ctl = (gu32*)(ws + WS_CTL);
    F.x = args.in[0]; F.norm_g = args.in[1]; F.w_in = args.in[2]; F.w_out = args.in[3]; F.a_qn = args.in[4]; F.a_kn = args.in[5]; F.pool_w = args.in[6]; F.pool_scale = args.in[7];
    F.c_qn = args.in[8]; F.c_kn = args.in[9]; F.c_sinks = args.in[10]; F.conv_w = args.in[11]; F.out = args.out;
    F.Win_t = (bf16*)(ws + WS_WIN); F.Wout_t = (bf16*)(ws + WS_WOUT); F.XB = (bf16*)(ws + WS_XB); F.Y = (bf16*)(ws + WS_Y); F.PROJ = (bf16*)(ws + WS_PROJ);
    F.kmean = (float*)(ws + WS_KMEAN); F.ssq1 = (float*)(ws + WS_SSQ1); F.ssq2 = (float*)(ws + WS_SSQ2);
    F.cnt = (unsigned*)(ws + WS_CNT); F.lst = (unsigned short*)(ws + WS_LST); F.partO = (bf16*)(ws + WS_PARTO); F.partL = (float*)(ws + WS_PARTL); F.Hu = (float*)(ws + WS_HALO); F.Hg = F.Hu + 256 * 2 * 256;
    for (int u = F.tid; u < (AUX_OFF - LDSCTL_OFF) / 4; u += NWAVES * 64) ((LAS unsigned*)(F.lds + LDSCTL_OFF))[u] = 0u;
    __syncthreads();
    XcdBarrier bar; bar.bar = (unsigned*)(F.ctl + CW_BAR); bar.x = 0; bar.st = nullptr;
    if (N_LAUNCHES == 1) bar = xcd_barrier_post((unsigned*)(F.ctl + CW_BAR), F.MISC + 8);
    const int lo = args.ph_lo, hi = args.ph_hi;
#define IN(k) (lo <= (k) && (k) < hi)
#define SEAM(k) do { if (IN(k) && IN((k) + 1)) { xcd_barrier(bar); if (PROBE_DUP == 7) xcd_barrier(bar); } } while (0)
    if (IN(0)) { p0_prologue(F); if (PROBE_DUP == 1) p0_prologue(F); } SEAM(0);
    for (int l = 0; l < NLAYER; ++l) {
        const int p0 = 1 + 5 * l;
        if (IN(p0)) {
            pg8::Gemm g{F.XB, F.Win_t + (size_t)l * NPROJ * 1024, M, 1792, DM}; pg8::StaticOrder S; S.init(M, 1792, F.G, (int)blockIdx.x);
            pg8::EpiInProj E{F.PROJ, l, 1};
            { F.refresh(); LAS float* gl = (LAS float*)(F.lds + AUX_OFF + 2048);
              if (F.tid < 256) { const float* src = (F.tid < 64 ? F.a_qn : F.tid < 128 ? F.a_kn : F.tid < 192 ? F.c_qn : F.c_kn) + l * 64 + (F.tid & 63); gl[F.tid] = *src; }
              { LAS float* cwl = (LAS float*)(F.lds + AUX_OFF + 4096); for (int i = F.tid; i < 768; i += NWAVES * 64) cwl[i] = F.conv_w[(size_t)l * 768 + i]; }
              __syncthreads(); }
            if (PROBE_DUP == 8) { pg8::EpiPlain E2{F.PROJ, NPROJ}; pg8::gemm_phase<pg8::EpiPlain, pg8::StaticOrder, true, true>(F.lds + RING_OFF, F.lds + AUX_OFF, g, S, E2); }
            if (PROBE_DUP == 9) { pg8::EpiNull E2{}; pg8::gemm_phase<pg8::EpiNull, pg8::StaticOrder, true, true>(F.lds + RING_OFF, F.lds + AUX_OFF, g, S, E2); }
            if (STAGGER_IN > 0) { const unsigned long long t0 = rt(); const unsigned long long dl = (unsigned long long)((F.vcu & 3) * STAGGER_IN); while (rt() - t0 < dl) __builtin_amdgcn_s_sleep(8); }
#if IN_ONE_CALL
            { pg8::Gemm ga{F.XB, F.Win_t + (size_t)l * NPROJ * 1024, M, NPROJ, DM}; pg8::StaticOrder Sa; Sa.init(M, NPROJ, F.G, (int)blockIdx.x); pg8::EpiInAll Ea{F.PROJ, l, 1};
              pg8::gemm_phase<pg8::EpiInAll, pg8::StaticOrder, true, true>(F.lds + RING_OFF, F.lds + AUX_OFF, ga, Sa, Ea); }
#else
            pg8::gemm_phase<pg8::EpiInProj, pg8::StaticOrder, true, true>(F.lds + RING_OFF, F.lds + AUX_OFF, g, S, E);
            { pg8::Gemm gp{F.XB, F.Win_t + (size_t)l * NPROJ * 1024 + (size_t)1792 * 1024, M, 1536, DM}; pg8::StaticOrder Sp; Sp.init(M, 1536, F.G, (int)blockIdx.x); pg8::EpiPoolConv Ep{F.PROJ, l};
              for (int rep = 0; rep < (PROBE_DUP == 14 ? 2 : 1); ++rep) pg8::gemm_phase<pg8::EpiPoolConv, pg8::StaticOrder, true, true>(F.lds + RING_OFF, F.lds + AUX_OFF, gp, Sp, Ep); }
#endif
            if (PROBE_DUP == 2) { pg8::EpiInProj E2 = E; E2.do_km = 0; pg8::gemm_phase<pg8::EpiInProj, pg8::StaticOrder, true, true>(F.lds + RING_OFF, F.lds + AUX_OFF, g, S, E2); }
        }
        SEAM(p0);
        if (IN(p0 + 1)) { F.refresh();
            moba_body::select_phase((char*)lds + SCR_OFF, F.PROJ, F.kmean + (size_t)l * 65536, F.cnt + (size_t)l * 32768, F.lst, F.vcu, F.G);
            for (int rep = 0; rep < (PROBE_DUP == 4 ? 2 : 1); ++rep) moba_body::swa_phase((char*)lds + RING_OFF, (char*)lds + SCR_OFF, F.PROJ, F.c_sinks + l * 4, F.Y, F.vcu, F.G); }
        SEAM(p0 + 1);
        if (IN(p0 + 2)) { F.refresh();
            for (int rep = 0; rep < (PROBE_DUP == 11 ? 2 : 1); ++rep) moba_body::gather_phase((char*)lds + RING_OFF, (char*)lds + SCR_OFF, F.PROJ, F.cnt + (size_t)l * 32768, F.lst, F.partO, F.partL, F.vcu);
        }
        SEAM(p0 + 2);
        if (IN(p0 + 3)) {
            for (int rep = 0; rep < (PROBE_DUP == 12 ? 2 : 1); ++rep) moba_body::own_merge_phase((char*)lds + RING_OFF, (char*)lds + SCR_OFF, F.PROJ, F.partO, F.partL, F.Y, F.vcu, F.G);
            convfix_phase(F, l); poolfix_phase(F, l); }
        SEAM(p0 + 3);
        if (IN(p0 + 4)) {
            pg8::Gemm g{F.Y, F.Wout_t + (size_t)l * 1024 * 1024, M, DM, DM}; pg8::StaticOrder S; S.init(M, DM, F.G, (int)blockIdx.x);
            pg8::EpiOutProj E{F.XB, l == 0 ? nullptr : F.out, l == 0 ? F.XB : nullptr, F.ssq2};
            if (PROBE_DUP == 10) { pg8::EpiNull E2{}; pg8::gemm_phase<pg8::EpiNull, pg8::StaticOrder, true, true>(F.lds + RING_OFF, F.lds + AUX_OFF, g, S, E2); }
            if (PROBE_DUP == 6) { pg8::EpiOutProj E2{F.XB, (float*)F.partO, nullptr, F.ssq2}; pg8::gemm_phase<pg8::EpiOutProj, pg8::StaticOrder, true, true>(F.lds + RING_OFF, F.lds + AUX_OFF, g, S, E2); }
            if (STAGGER_OUT > 0) { const unsigned long long t0 = rt(); const unsigned long long dl = (unsigned long long)((F.vcu & 3) * STAGGER_OUT); while (rt() - t0 < dl) __builtin_amdgcn_s_sleep(8); }
            pg8::gemm_phase<pg8::EpiOutProj, pg8::StaticOrder, true, true>(F.lds + RING_OFF, F.lds + AUX_OFF, g, S, E);
        }
        if (l + 1 < NLAYER) SEAM(p0 + 4);
    }
#undef IN
#undef SEAM
}
extern "C" void kernel_launch(void* const* d_in, const int* in_sizes, int n_in, void* d_out, int out_size, void* d_ws, size_t ws_size, hipStream_t stream) {
    static int grid = 0;
    if (grid == 0) {
        if (n_in != 12 || in_sizes[0] != M * DM || out_size != M * DM || ws_size < WS_END) { fprintf(stderr, "kernel_launch: unexpected shapes (n_in %d, in0 %d, out %d, ws %zu); nothing launched\n", n_in, n_in > 0 ? in_sizes[0] : -1, out_size, ws_size); grid = -1; return; }
        int dev = 0, cus = 0;
        if (hipGetDevice(&dev) != hipSuccess || hipDeviceGetAttribute(&cus, hipDeviceAttributeMultiprocessorCount, dev) != hipSuccess) { grid = -1; return; }
        if (hipFuncSetAttribute((const void*)hybrid_fwd, hipFuncAttributeMaxDynamicSharedMemorySize, LDS_BYTES) != hipSuccess) { fprintf(stderr, "kernel_launch: hipFuncSetAttribute failed\n"); grid = -1; return; }
        (void)hipGetLastError();
        grid = cus;
    }
    if (grid < 0) return;
    if (hipMemsetAsync((char*)d_ws + WS_CTL, 0, 64 * 1024, stream) != hipSuccess) return;
    Args a{};
    for (int i = 0; i < 12; ++i) a.in[i] = (const float*)d_in[i];
    a.out = (float*)d_out; a.ws = (unsigned char*)d_ws;
    for (int li = 0; li < N_LAUNCHES; ++li) {
        a.ph_lo = (N_LAUNCHES == 1) ? 0 : li; a.ph_hi = (N_LAUNCHES == 1) ? N_PHASES : li + 1; a.li = li;
        hipLaunchKernelGGL(hybrid_fwd, dim3(grid), dim3(NWAVES * 64), LDS_BYTES, stream, a);
    }
}
```

```cpp
#include <hip/hip_runtime.h>
#include <cstdio>
#include <cstdint>
#include <cmath>
constexpr int NB = 8, SEQ = 8192, DM = 1024, NPROJ = 3328, M = NB * SEQ, NLAYER = 2;
constexpr int C_AQ = 0, C_AK = 256, C_AV = 512, C_AG = 768, C_BU = 1024, C_BG = 1280, C_CQ = 1536, C_CK = 1792, C_CV = 1920, C_CG = 2048, C_DH = 2304, C_DB = 2560, C_DC = 2816, C_DG = 3072;
#ifndef PROBE_DUP
#define PROBE_DUP 0
#endif

constexpr size_t OFF_QA = 0, OFF_KA = 16ull << 20, OFF_VA = 32ull << 20, OFF_GA = 48ull << 20, OFF_QC = 64ull << 20, OFF_KC = 80ull << 20, OFF_VC = 88ull << 20, OFF_GC = 96ull << 20;
__host__ __device__ __forceinline__ int phys_row(int c) {
    if (c >= C_DH) { const int op = (c - C_DH) >> 8, ch = (c - C_DH) & 255, j = ch >> 6, wc = (ch >> 4) & 3, fq = (ch >> 2) & 3, e = ch & 3; return (9 + j) * 256 + 128 * (op >> 1) + 32 * wc + 8 * fq + 4 * (op & 1) + e; }
    if (c >= C_BU && c < C_CQ) { const int gate = c >= C_BG, ch = c - (gate ? C_BG : C_BU); return (7 + (ch >> 7)) * 256 + 128 * gate + (ch & 127); }
    const int lt = c >> 8, t = lt < 4 ? lt : lt - 2, cc = c & 255; return t * 256 + 128 * ((cc >> 5) & 1) + 32 * (cc >> 6) + (cc & 31);
}

constexpr size_t MiB = 1u << 20;
constexpr size_t WS_CTL = 0, CTL_ZERO_BYTES = 2 * MiB;
constexpr size_t WS_KMEAN = 256 * 1024;
constexpr size_t WS_SSQ2 = 1 * MiB;
constexpr size_t WS_SSQ1 = 2 * MiB;
constexpr size_t WS_WIN = 4 * MiB;
constexpr size_t WS_WOUT = 18 * MiB;
constexpr size_t WS_XB = 32 * MiB;
constexpr size_t WS_Y = 160 * MiB;
constexpr size_t WS_PROJ = 288 * MiB;
constexpr size_t WS_LST = 704 * MiB;
constexpr size_t WS_CNT = 1280 * 1024;
constexpr size_t WS_PARTL = 721 * MiB;
constexpr size_t WS_HALO = 726 * MiB;
constexpr size_t WS_PHALO = 727 * MiB;
constexpr size_t WS_PARTO = 736 * MiB;
constexpr size_t WS_END = 864 * MiB;
namespace pg8 {
#define PG8_LAS __attribute__((address_space(3)))
typedef unsigned short bf16_t;
typedef short bf16x8 __attribute__((ext_vector_type(8)));
typedef float f32x4 __attribute__((ext_vector_type(4)));
typedef unsigned u32x4 __attribute__((ext_vector_type(4)));
constexpr int BM = 256, BK = 64, HALF = 128, HTB = HALF * BK * 2  , STAGE_BYTES = 8 * HTB, NXCD = 8, WGM = 8;

__host__ __device__ __forceinline__ int lds_byte(int r, int c) { const int st = (r >> 4) * 2 + (c >> 5), rr = r & 15, cc = c & 31, ob = rr * 64 + cc * 2; return st * 1024 + (ob ^ (((ob >> 9) & 1) << 5)); }
__host__ __device__ __forceinline__ void stage_rc(int b, int& R, int& C) { const int st = b / 1024, sb = b % 1024, swz = sb ^ (((sb >> 9) & 1) << 5); R = (st >> 1) * 16 + swz / 64; C = (st & 1) * 32 + (swz % 64) / 2; }
__host__ __device__ __forceinline__ int perm32(int rho) { const int n = rho >> 4, i = rho & 15; return 8 * (i >> 2) + 4 * n + (i & 3); }

struct Unit { int pm, pn; };
struct Gemm { const bf16_t* A; const bf16_t* Bt; int M, N, K; };

struct StaticOrder {
    int nM, nN, nwg, G, c;
    __host__ __device__ void init(int M, int N, int G_, int c_) { nM = M / BM; nN = N / BM; nwg = nM * nN; G = G_; c = c_; }
    __host__ __device__ bool next(int i, Unit& u) const {
        const long L = (long)i * G + c; if (L >= nwg) return false;
        int wgid = (int)L; { const int q = nwg / NXCD, r = nwg % NXCD, xcd = wgid % NXCD, off = wgid / NXCD; wgid = (xcd < r ? xcd * (q + 1) : r * (q + 1) + (xcd - r) * q) + off; }
        const int nig = WGM * nN, gid = wgid / nig, fm = gid * WGM, gsz = (nM - fm) < WGM ? (nM - fm) : WGM;
        u.pm = fm + ((wgid % nig) % gsz); u.pn = (wgid % nig) / gsz; return true;
    }
    __device__ __forceinline__ void a_ready(const Unit&) const {}
    __device__ __forceinline__ void done(const Unit&) const {}
};

typedef float pg8_f32x2 __attribute__((ext_vector_type(2))); typedef __bf16 pg8_bf16x2 __attribute__((ext_vector_type(2)));
__device__ __forceinline__ unsigned cvt_pk_bf16(float lo, float hi) { pg8_f32x2 v = {lo, hi}; pg8_bf16x2 b = __builtin_convertvector(v, pg8_bf16x2); return __builtin_bit_cast(unsigned, b); }
typedef float f32x2 __attribute__((ext_vector_type(2)));
#define PG8_GAS __attribute__((address_space(1)))
constexpr float QK_C2 = 0.125f * 1.4426950408889634f;
struct EpiInProj {
    static constexpr bool PERM = true, AFTER_DRAIN = false;
    bf16_t* P; int layer; int do_km;
    __device__ __forceinline__ char* wsb() const { return (char*)P - WS_PROJ; }
    __device__ __forceinline__ void prefetch(PG8_LAS unsigned char* aux, const Unit& u, int ui, int wid, int lane) const {
        const float* ssq = (const float*)(wsb() + (layer == 0 ? WS_SSQ1 : WS_SSQ2));
        if (wid == 0) __builtin_amdgcn_global_load_lds((const unsigned*)(ssq + (size_t)u.pm * BM + lane * 4), (PG8_LAS unsigned*)(aux + (ui & 1) * 1024), 16, 0, 0);
    }
    __device__ __forceinline__ void operator()(const f32x4 (&acc)[2][2][4][2], const Unit& u, int wr, int wc, int fr_in, int fq_in, PG8_LAS unsigned char* aux, int ui) const {
        int fr = fr_in, fq = fq_in; asm volatile("" : "+v"(fr), "+v"(fq));
        const int pn = u.pn;
        const PG8_LAS float* rv = (const PG8_LAS float*)(aux + (ui & 1) * 1024); const PG8_LAS float* gl = (const PG8_LAS float*)(aux + 2048);
        int g = -1; float post = 1.f; bool silu = false, km = false;
        const int lt = pn < 4 ? pn : pn + 2;
        if (lt == 0) { g = 0; post = QK_C2; } else if (lt == 1) { g = 64; km = (do_km != 0); } else if (lt == 6) { g = 128; post = QK_C2; }
        else if (lt == 7) { if (wc < 2) g = 192; } else if (lt == 3 || lt == 8) silu = true;
        float scl[2][4];
#pragma unroll
        for (int ai = 0; ai < 2; ++ai)
#pragma unroll
            for (int m = 0; m < 4; ++m) {
                float sr = __builtin_amdgcn_rsqf(rv[ai * HALF + wr * 64 + m * 16 + fr] * (1.0f / 1024.0f) + 1e-6f);
                if (g >= 0) { float ss = 0.f;
#pragma unroll
                    for (int bj = 0; bj < 2; ++bj)
#pragma unroll
                        for (int n = 0; n < 2; ++n) { const f32x4 q = acc[ai][bj][m][n] * acc[ai][bj][m][n]; ss += (q[0] + q[1]) + (q[2] + q[3]); }
                    ss += __shfl_xor(ss, 16); ss += __shfl_xor(ss, 32);
                    sr = sr * post * __builtin_amdgcn_rsqf(ss * sr * sr * (1.0f / 64.0f) + 1e-6f); }
                scl[ai][m] = sr; }
        const int bb = u.pm >> 5;
        size_t hbase;
        if (lt == 0) hbase = OFF_QA + (size_t)(bb * 4 + wc) * SEQ * 64; else if (lt == 1) hbase = OFF_KA + (size_t)(bb * 4 + wc) * SEQ * 64; else if (lt == 2) hbase = OFF_VA + (size_t)(bb * 4 + wc) * SEQ * 64;
        else if (lt == 3) hbase = OFF_GA + (size_t)(bb * 4 + wc) * SEQ * 64; else if (lt == 6) hbase = OFF_QC + (size_t)(bb * 4 + wc) * SEQ * 64;
        else if (lt == 7) hbase = (wc < 2 ? OFF_KC + (size_t)(bb * 2 + wc) * SEQ * 64 : OFF_VC + (size_t)(bb * 2 + wc - 2) * SEQ * 64); else hbase = OFF_GC + (size_t)(bb * 4 + wc) * SEQ * 64;
        const int lcol = 8 * fq + ((fr >> 3) << 5); const bool lo8 = fr < 8;
        f32x4 cs[2][2], gq[2][2];
#pragma unroll
        for (int bj = 0; bj < 2; ++bj) { cs[bj][0] = (f32x4){0.f, 0.f, 0.f, 0.f}; cs[bj][1] = cs[bj][0]; gq[bj][0] = (f32x4){1.f, 1.f, 1.f, 1.f}; gq[bj][1] = gq[bj][0];
            if (g >= 0) { gq[bj][0] = *(const PG8_LAS f32x4*)(gl + g + 32 * bj + 8 * fq); gq[bj][1] = *(const PG8_LAS f32x4*)(gl + g + 32 * bj + 8 * fq + 4); } }
#pragma unroll
        for (int ai = 0; ai < 2; ++ai)
#pragma unroll
            for (int m = 0; m < 4; ++m) {
                u32x4 w[2];
#pragma unroll
                for (int bj = 0; bj < 2; ++bj) {
                    f32x4 v0 = acc[ai][bj][m][0] * scl[ai][m] * gq[bj][0], v1 = acc[ai][bj][m][1] * scl[ai][m] * gq[bj][1];
                    if (silu) {
#pragma unroll
                        for (int e = 0; e < 4; ++e) { v0[e] = v0[e] * __builtin_amdgcn_rcpf(1.0f + __builtin_amdgcn_exp2f(-1.4426950408889634f * v0[e])); v1[e] = v1[e] * __builtin_amdgcn_rcpf(1.0f + __builtin_amdgcn_exp2f(-1.4426950408889634f * v1[e])); } }
                    if (km) { cs[bj][0] += v0; cs[bj][1] += v1; }
                    w[bj].x = cvt_pk_bf16(v0[0], v0[1]); w[bj].y = cvt_pk_bf16(v0[2], v0[3]); w[bj].z = cvt_pk_bf16(v1[0], v1[1]); w[bj].w = cvt_pk_bf16(v1[2], v1[3]); }
                u32x4 st1, st2;
#pragma unroll
                for (int e = 0; e < 4; ++e) { const unsigned give = lo8 ? w[1][e] : w[0][e]; const unsigned recv = (unsigned)__builtin_amdgcn_mov_dpp((int)give, 0x128, 0xf, 0xf, false);
                    st1[e] = lo8 ? w[0][e] : recv; st2[e] = lo8 ? recv : w[1][e]; }
                const size_t t0 = (size_t)((u.pm & 31) * BM + ai * HALF + wr * 64 + m * 16 + (fr & 7));
                __builtin_nontemporal_store(st1, (PG8_GAS u32x4*)(P + hbase + t0 * 64 + lcol)); __builtin_nontemporal_store(st2, (PG8_GAS u32x4*)(P + hbase + (t0 + 8) * 64 + lcol)); }
        if (km) {
#pragma unroll
            for (int bj = 0; bj < 2; ++bj) {
                float* kmp = (float*)(wsb() + WS_KMEAN) + (size_t)layer * 65536 + ((size_t)((u.pm >> 5) * 4 + wc) * 32 + (u.pm & 31)) * 64 + 32 * bj + 8 * fq;
#pragma unroll
                for (int e = 0; e < 8; ++e) { float s = e < 4 ? cs[bj][0][e & 3] : cs[bj][1][e & 3]; s += __shfl_xor(s, 1); s += __shfl_xor(s, 2); s += __shfl_xor(s, 4); s += __shfl_xor(s, 8);
                    if (fr == 0) __hip_atomic_fetch_add((PG8_GAS float*)(kmp + e), s * (1.0f / 256.0f), __ATOMIC_RELAXED, __HIP_MEMORY_SCOPE_AGENT); } } }
    }
};

struct EpiConv {
    static constexpr bool PERM = true, AFTER_DRAIN = false;
    bf16_t* P; int layer;
    __device__ __forceinline__ char* wsb() const { return (char*)P - WS_PROJ; }
    __device__ __forceinline__ void prefetch(PG8_LAS unsigned char* aux, const Unit& u, int ui, int wid, int lane) const {
        const float* ssq = (const float*)(wsb() + (layer == 0 ? WS_SSQ1 : WS_SSQ2));
        if (wid == 0) __builtin_amdgcn_global_load_lds((const unsigned*)(ssq + (size_t)u.pm * BM + lane * 4), (PG8_LAS unsigned*)(aux + (ui & 1) * 1024), 16, 0, 0);
    }
    __device__ __forceinline__ void operator()(const f32x4 (&acc)[2][2][4][2], const Unit& u, int wr, int wc, int fr_in, int fq_in, PG8_LAS unsigned char* aux, int ui) const {
        int fr = fr_in, fq = fq_in; asm volatile("" : "+v"(fr), "+v"(fq));
        const PG8_LAS float* rv = (const PG8_LAS float*)(aux + (ui & 1) * 1024);
        float scl[2][4];
#pragma unroll
        for (int ai = 0; ai < 2; ++ai)
#pragma unroll
            for (int m = 0; m < 4; ++m) scl[ai][m] = __builtin_amdgcn_rsqf(rv[ai * HALF + wr * 64 + m * 16 + fr] * (1.0f / 1024.0f) + 1e-6f);
        {
            const int j = u.pn, chg = 64 * j + 16 * wc + 4 * fq;
            bf16_t* Y = (bf16_t*)(wsb() + WS_Y); float* Hu = (float*)(wsb() + WS_HALO); float* Hg = Hu + 256 * 2 * 256;
            const PG8_LAS float* cw = (const PG8_LAS float*)(aux + 4096); PG8_LAS float* hx = (PG8_LAS float*)(aux + 8192);
            const f32x4 w0 = *(const PG8_LAS f32x4*)(cw + chg), w1 = *(const PG8_LAS f32x4*)(cw + 256 + chg), w2 = *(const PG8_LAS f32x4*)(cw + 512 + chg);
            if (fr >= 14) {
#pragma unroll
                for (int ai = 0; ai < 2; ++ai) { const float sc = scl[ai][3]; *(PG8_LAS f32x4*)(hx + (((2 * ai + wr) * 4 + wc) * 2 + (fr - 14)) * 16 + 4 * fq) = (acc[ai][1][3][0] * sc) * (acc[ai][0][3][0] * sc); } }
            asm volatile("s_waitcnt lgkmcnt(0)" ::: "memory"); __builtin_amdgcn_s_barrier(); asm volatile("" ::: "memory");
#pragma unroll
            for (int ai = 0; ai < 2; ++ai) {
                const int seg = 2 * ai + wr; f32x4 h1 = (f32x4){0.f, 0.f, 0.f, 0.f}, h2 = h1;
                if (seg > 0) { h2 = *(const PG8_LAS f32x4*)(hx + (((seg - 1) * 4 + wc) * 2 + 0) * 16 + 4 * fq); h1 = *(const PG8_LAS f32x4*)(hx + (((seg - 1) * 4 + wc) * 2 + 1) * 16 + 4 * fq); }
                f32x4 prv = (f32x4){0.f, 0.f, 0.f, 0.f};
#pragma unroll
                for (int m = 0; m < 4; ++m) {
                    const float sc = scl[ai][m]; const f32x4 cur = (acc[ai][1][m][0] * sc) * (acc[ai][0][m][0] * sc); f32x4 u1, u2;
#pragma unroll
                    for (int e2 = 0; e2 < 4; ++e2) {
                        const float c1 = __int_as_float(__builtin_amdgcn_update_dpp(0, __float_as_int(cur[e2]), 0x121, 0xf, 0xf, false)), c2 = __int_as_float(__builtin_amdgcn_update_dpp(0, __float_as_int(cur[e2]), 0x122, 0xf, 0xf, false));
                        float p1, p2;
                        if (m > 0) { const float pv_ = prv[e2]; p1 = __int_as_float(__builtin_amdgcn_update_dpp(0, __float_as_int(pv_), 0x121, 0xf, 0xf, false)); p2 = __int_as_float(__builtin_amdgcn_update_dpp(0, __float_as_int(pv_), 0x122, 0xf, 0xf, false)); }
                        else { p1 = h1[e2]; p2 = (fr == 1) ? h1[e2] : h2[e2]; }
                        u1[e2] = fr >= 1 ? c1 : p1; u2[e2] = fr >= 2 ? c2 : p2; }
                    const f32x4 dbv = acc[ai][0][m][1] * sc, dgv = acc[ai][1][m][1] * sc; f32x4 gg;
#pragma unroll
                    for (int e2 = 0; e2 < 4; ++e2) gg[e2] = dbv[e2] * dgv[e2] * __builtin_amdgcn_rcpf(1.0f + __builtin_amdgcn_exp2f(-1.4426950408889634f * dgv[e2]));
                    const f32x4 o = gg * (w0 * u2 + w1 * u1 + w2 * cur);
                    const size_t r = (size_t)(u.pm * BM + ai * HALF + wr * 64 + m * 16 + fr);
                    typedef unsigned u32x2 __attribute__((ext_vector_type(2)));
                    u32x2 w; w.x = cvt_pk_bf16(o[0], o[1]); w.y = cvt_pk_bf16(o[2], o[3]); *(PG8_GAS u32x2*)(Y + r * 1024 + 768 + chg) = w;
                    if (seg == 3 && m == 3 && fr >= 14) *(PG8_GAS f32x4*)(Hu + ((size_t)u.pm * 2 + (fr - 14)) * 256 + chg) = cur;
                    if (seg == 0 && m == 0 && fr < 2) *(PG8_GAS f32x4*)(Hg + ((size_t)u.pm * 2 + fr) * 256 + chg) = gg;
                    prv = cur;
                    __builtin_amdgcn_sched_barrier(0);
                }
            }
        }
    }
};

template <int K> __device__ __forceinline__ float row_shift(float cur, float prev, int fr) {
    const float a = __int_as_float(__builtin_amdgcn_update_dpp(0, __float_as_int(cur), 0x120 + K, 0xf, 0xf, false)), b = __int_as_float(__builtin_amdgcn_update_dpp(0, __float_as_int(prev), 0x120 + K, 0xf, 0xf, false));
    return fr >= K ? a : b;
}
struct EpiPool {
    static constexpr bool PERM = true, AFTER_DRAIN = false;
    bf16_t* P; int layer;
    __device__ __forceinline__ char* wsb() const { return (char*)P - WS_PROJ; }
    __device__ __forceinline__ void prefetch(PG8_LAS unsigned char* aux, const Unit& u, int ui, int wid, int lane) const {
        const float* ssq = (const float*)(wsb() + (layer == 0 ? WS_SSQ1 : WS_SSQ2));
        if (wid == 0) __builtin_amdgcn_global_load_lds((const unsigned*)(ssq + (size_t)u.pm * BM + lane * 4), (PG8_LAS unsigned*)(aux + (ui & 1) * 1024), 16, 0, 0);
    }
    __device__ __forceinline__ void operator()(const f32x4 (&acc)[2][2][4][2], const Unit& u, int wr, int wc, int fr_in, int fq_in, PG8_LAS unsigned char* aux, int ui) const {
        int fr = fr_in, fq = fq_in; asm volatile("" : "+v"(fr), "+v"(fq));
        const PG8_LAS float* rv = (const PG8_LAS float*)(aux + (ui & 1) * 1024);
        float scl[2][4];
#pragma unroll
        for (int ai = 0; ai < 2; ++ai)
#pragma unroll
            for (int m = 0; m < 4; ++m) scl[ai][m] = __builtin_amdgcn_rsqf(rv[ai * HALF + wr * 64 + m * 16 + fr] * (1.0f / 1024.0f) + 1e-6f);
        const int j = u.pn, grp = 2 * j + (wc >> 1), w = 2 << grp, chg = 128 * j + 32 * wc + 8 * fq;
        bf16_t* Y = (bf16_t*)(wsb() + WS_Y); float* Hpu = (float*)(wsb() + WS_PHALO); float* Hpg = Hpu + 256 * 16 * 256;
        PG8_LAS unsigned char* hx = aux + 8192;
#pragma unroll
        for (int ai = 0; ai < 2; ++ai) { const float sc = scl[ai][3]; const f32x4 v0 = acc[ai][0][3][0] * sc, v1 = acc[ai][0][3][1] * sc;
            u32x4 q; q.x = cvt_pk_bf16(v0[0], v0[1]); q.y = cvt_pk_bf16(v0[2], v0[3]); q.z = cvt_pk_bf16(v1[0], v1[1]); q.w = cvt_pk_bf16(v1[2], v1[3]);
            *(PG8_LAS u32x4*)(hx + ((2 * ai + wr) * 4 + wc) * 1024 + fr * 64 + fq * 16) = q; }
        asm volatile("s_waitcnt lgkmcnt(0)" ::: "memory"); __builtin_amdgcn_s_barrier(); asm volatile("" ::: "memory");
        const bool seqstart = (u.pm & 31) == 0;
#pragma unroll
        for (int ai = 0; ai < 2; ++ai) {
            const int seg = 2 * ai + wr; float hal[8];
            if (seg > 0) { const u32x4 q = *(const PG8_LAS u32x4*)(hx + ((seg - 1) * 4 + wc) * 1024 + fr * 64 + fq * 16);
                hal[0] = __uint_as_float(q.x << 16); hal[1] = __uint_as_float(q.x & 0xffff0000u); hal[2] = __uint_as_float(q.y << 16); hal[3] = __uint_as_float(q.y & 0xffff0000u);
                hal[4] = __uint_as_float(q.z << 16); hal[5] = __uint_as_float(q.z & 0xffff0000u); hal[6] = __uint_as_float(q.w << 16); hal[7] = __uint_as_float(q.w & 0xffff0000u); }
            else {
#pragma unroll
                for (int c8 = 0; c8 < 8; ++c8) hal[c8] = 0.f; }
            float S[4][8];
#pragma unroll
            for (int c8 = 0; c8 < 8; ++c8) {
                float x0 = hal[c8], x1 = acc[ai][0][0][c8 >> 2][c8 & 3] * scl[ai][0], x2 = acc[ai][0][1][c8 >> 2][c8 & 3] * scl[ai][1], x3 = acc[ai][0][2][c8 >> 2][c8 & 3] * scl[ai][2], x4 = acc[ai][0][3][c8 >> 2][c8 & 3] * scl[ai][3];
#define POOL_STEP(K) if (K < w) { x4 += row_shift<K>(x4, x3, fr); x3 += row_shift<K>(x3, x2, fr); x2 += row_shift<K>(x2, x1, fr); x1 += row_shift<K>(x1, x0, fr); x0 += row_shift<K>(x0, 0.f, fr); }
                POOL_STEP(1) POOL_STEP(2) POOL_STEP(4) POOL_STEP(8)
#undef POOL_STEP
                S[0][c8] = x1; S[1][c8] = x2; S[2][c8] = x3; S[3][c8] = x4; }
#pragma unroll
            for (int m = 0; m < 4; ++m) {
                const float sc = scl[ai][m]; const int t = 16 * m + fr;
                const float ic = (seqstart && seg == 0 && t < w - 1) ? __builtin_amdgcn_rcpf((float)(t + 1)) : __builtin_amdgcn_rcpf((float)w);
                float o[8], uu[8], gg[8];
#pragma unroll
                for (int c8 = 0; c8 < 8; ++c8) { uu[c8] = acc[ai][0][m][c8 >> 2][c8 & 3] * sc; const float gv = acc[ai][1][m][c8 >> 2][c8 & 3] * sc;
                    gg[c8] = gv * __builtin_amdgcn_rcpf(1.0f + __builtin_amdgcn_exp2f(-1.4426950408889634f * gv)); o[c8] = (S[m][c8] * ic - uu[c8]) * gg[c8]; }
                const size_t r = (size_t)(u.pm * BM + ai * HALF + wr * 64 + m * 16 + fr);
                u32x4 q; q.x = cvt_pk_bf16(o[0], o[1]); q.y = cvt_pk_bf16(o[2], o[3]); q.z = cvt_pk_bf16(o[4], o[5]); q.w = cvt_pk_bf16(o[6], o[7]);
                *(PG8_GAS u32x4*)(Y + r * 1024 + 256 + chg) = q;
                if (seg == 3 && m == 3) { float* hp = Hpu + ((size_t)u.pm * 16 + fr) * 256 + chg; *(PG8_GAS f32x4*)hp = (f32x4){uu[0], uu[1], uu[2], uu[3]}; *(PG8_GAS f32x4*)(hp + 4) = (f32x4){uu[4], uu[5], uu[6], uu[7]}; }
                if (seg == 0 && m == 0) { float* hp = Hpg + ((size_t)u.pm * 16 + fr) * 256 + chg; *(PG8_GAS f32x4*)hp = (f32x4){gg[0], gg[1], gg[2], gg[3]}; *(PG8_GAS f32x4*)(hp + 4) = (f32x4){gg[4], gg[5], gg[6], gg[7]}; }
                __builtin_amdgcn_sched_barrier(0);
            }
        }
    }
};

struct EpiPoolConv {
    static constexpr bool PERM = true, AFTER_DRAIN = false;
    bf16_t* P; int layer;
    __device__ __forceinline__ void prefetch(PG8_LAS unsigned char* aux, const Unit& u, int ui, int wid, int lane) const { EpiPool E{P, layer}; E.prefetch(aux, u, ui, wid, lane); }
    __device__ __forceinline__ void operator()(const f32x4 (&acc)[2][2][4][2], const Unit& u, int wr, int wc, int fr, int fq, PG8_LAS unsigned char* aux, int ui) const {
        if (u.pn < 2) { EpiPool E{P, layer}; E(acc, u, wr, wc, fr, fq, aux, ui); }
        else { EpiConv E{P, layer}; Unit v = u; v.pn = u.pn - 2; E(acc, v, wr, wc, fr, fq, aux, ui); }
    }
};

struct EpiInAll {
    static constexpr bool PERM = true, AFTER_DRAIN = false;
    bf16_t* P; int layer; int do_km;
    __device__ __forceinline__ void prefetch(PG8_LAS unsigned char* aux, const Unit& u, int ui, int wid, int lane) const { EpiPool E{P, layer}; E.prefetch(aux, u, ui, wid, lane); }
    __device__ __forceinline__ void operator()(const f32x4 (&acc)[2][2][4][2], const Unit& u, int wr, int wc, int fr, int fq, PG8_LAS unsigned char* aux, int ui) const {
        if (u.pn < 7) { EpiInProj E{P, layer, do_km}; E(acc, u, wr, wc, fr, fq, aux, ui); }
        else if (u.pn < 9) { EpiPool E{P, layer}; Unit v = u; v.pn = u.pn - 7; E(acc, v, wr, wc, fr, fq, aux, ui); }
        else { EpiConv E{P, layer}; Unit v = u; v.pn = u.pn - 9; E(acc, v, wr, wc, fr, fq, aux, ui); }
    }
};
struct EpiOutProj {
    static constexpr bool PERM = true, AFTER_DRAIN = false;
    const bf16_t* xin_b; float* xout; bf16_t* xb; float* ssq;
    __device__ __forceinline__ void prefetch(PG8_LAS unsigned char*, const Unit&, int, int, int) const {}
    __device__ __forceinline__ f32x4 xch(const f32x4 give) const { f32x4 r;
#pragma unroll
        for (int e = 0; e < 4; ++e) r[e] = __int_as_float(__builtin_amdgcn_update_dpp(0, __float_as_int(give[e]), 0x128, 0xf, 0xf, false));
        return r; }
    __device__ __forceinline__ void operator()(const f32x4 (&acc)[2][2][4][2], const Unit& u, int wr, int wc, int fr_in, int fq_in, PG8_LAS unsigned char*, int) const {
        int fr = fr_in, fq = fq_in; asm volatile("" : "+v"(fr), "+v"(fq));
        const int col0 = u.pn * BM + wc * 32 + 8 * fq; const bool lo8 = fr < 8; const int cpart = lo8 ? 0 : 4;
        u32x4 rb[2][4][2];
#pragma unroll
        for (int ai = 0; ai < 2; ++ai)
#pragma unroll
            for (int m = 0; m < 4; ++m)
#pragma unroll
                for (int bj = 0; bj < 2; ++bj) rb[ai][m][bj] = __builtin_nontemporal_load((const PG8_GAS u32x4*)(xin_b + (size_t)(u.pm * BM + ai * HALF + wr * 64 + m * 16 + fr) * 1024 + col0 + bj * HALF));
#pragma unroll
        for (int ai = 0; ai < 2; ++ai)
#pragma unroll
            for (int m = 0; m < 4; ++m) {
                const int rg = u.pm * BM + ai * HALF + wr * 64 + m * 16; const int r = rg + fr; const size_t off = (size_t)r * 1024 + col0; float ss = 0.f;
                const size_t offA = (size_t)(rg + (fr & 7)) * 1024 + col0 + cpart, offB = offA + 8 * 1024;
#pragma unroll
                for (int bj = 0; bj < 2; ++bj) { const u32x4 q = rb[ai][m][bj];
                    const f32x4 r0 = (f32x4){__uint_as_float(q.x << 16), __uint_as_float(q.x & 0xffff0000u), __uint_as_float(q.y << 16), __uint_as_float(q.y & 0xffff0000u)};
                    const f32x4 r1 = (f32x4){__uint_as_float(q.z << 16), __uint_as_float(q.z & 0xffff0000u), __uint_as_float(q.w << 16), __uint_as_float(q.w & 0xffff0000u)};
                    const f32x4 v0 = acc[ai][bj][m][0] + r0, v1 = acc[ai][bj][m][1] + r1;
                    if (xout) { const f32x4 rc = xch(lo8 ? v1 : v0); const f32x4 s1 = lo8 ? v0 : rc, s2 = lo8 ? rc : v1;
                        __builtin_nontemporal_store(s1, (PG8_GAS f32x4*)(xout + offA + bj * HALF)); __builtin_nontemporal_store(s2, (PG8_GAS f32x4*)(xout + offB + bj * HALF)); }
                    if (xb) { u32x4 w; w.x = cvt_pk_bf16(v0[0], v0[1]); w.y = cvt_pk_bf16(v0[2], v0[3]); w.z = cvt_pk_bf16(v1[0], v1[1]); w.w = cvt_pk_bf16(v1[2], v1[3]); *(PG8_GAS u32x4*)(xb + off + bj * HALF) = w;
                        const f32x4 q0 = v0 * v0, q1 = v1 * v1; ss += ((q0[0] + q0[1]) + (q0[2] + q0[3])) + ((q1[0] + q1[1]) + (q1[2] + q1[3])); } }
                if (xb) { ss += __shfl_xor(ss, 16); ss += __shfl_xor(ss, 32); if (fq == 0) __hip_atomic_fetch_add((PG8_GAS float*)(ssq + r), ss, __ATOMIC_RELAXED, __HIP_MEMORY_SCOPE_AGENT); }
            }
    }
};

struct EpiNull {
    static constexpr bool PERM = true, AFTER_DRAIN = false;
    __device__ __forceinline__ void prefetch(PG8_LAS unsigned char*, const Unit&, int, int, int) const {}
    __device__ __forceinline__ void operator()(const f32x4 (&acc)[2][2][4][2], const Unit& u, int wr, int wc, int fr, int fq, PG8_LAS unsigned char*, int) const {
#pragma unroll
        for (int ai = 0; ai < 2; ++ai)
#pragma unroll
            for (int bj = 0; bj < 2; ++bj)
#pragma unroll
                for (int m = 0; m < 4; ++m)
#pragma unroll
                    for (int n = 0; n < 2; ++n) asm volatile("" :: "v"(acc[ai][bj][m][n]));
    }
};
struct EpiPlain {
    static constexpr bool PERM = true, AFTER_DRAIN = false;
    bf16_t* P; int ldc;
    __device__ __forceinline__ void prefetch(PG8_LAS unsigned char*, const Unit&, int, int, int) const {}
    __device__ __forceinline__ void operator()(const f32x4 (&acc)[2][2][4][2], const Unit& u, int wr, int wc, int fr, int fq, PG8_LAS unsigned char*, int) const {
        const int lcol = u.pn * 256 + 64 * wc + 8 * fq;
#pragma unroll
        for (int bj = 0; bj < 2; ++bj)
#pragma unroll
            for (int ai = 0; ai < 2; ++ai)
#pragma unroll
                for (int m = 0; m < 4; ++m) { const int r = u.pm * BM + ai * HALF + wr * 64 + m * 16 + fr; const f32x4 v0 = acc[ai][bj][m][0], v1 = acc[ai][bj][m][1];
                    u32x4 w; w.x = cvt_pk_bf16(v0[0], v0[1]); w.y = cvt_pk_bf16(v0[2], v0[3]); w.z = cvt_pk_bf16(v1[0], v1[1]); w.w = cvt_pk_bf16(v1[2], v1[3]);
                    *(PG8_GAS u32x4*)(P + (size_t)r * ldc + lcol + 32 * bj) = w; }
    }
};
template <class Epi, class Sched, bool ALIGN_EPI = false, bool SP2 = false>
__device__ __forceinline__ void gemm_phase(PG8_LAS unsigned char* lds, PG8_LAS unsigned char* aux, const Gemm g, const Sched& S, const Epi& E) {
    int tid_ = threadIdx.x; asm volatile("" : "+v"(tid_));
    const int tid = tid_, wid = __builtin_amdgcn_readfirstlane(tid >> 6), lane = tid & 63, wr = wid >> 2, wc = wid & 3, fr = lane & 15, fq = lane >> 4;
    const int K = g.K, nt = K / BK;
    unsigned voffA[2], voffB[2];
#pragma unroll
    for (int i = 0; i < 2; ++i) { int R, C; stage_rc(tid * 16 + i * 8192, R, C); const int Rb = Epi::PERM ? ((R & ~31) + perm32(R & 31)) : R;
        voffA[i] = (unsigned)(R * K + C) * 2u; voffB[i] = (unsigned)(Rb * K + C) * 2u; }
    const size_t kstep = (size_t)(BK * 2);
    const size_t hstep = (size_t)HALF * K * 2;
    const size_t tstep = 2 * hstep;
    const unsigned ldsw = (unsigned)wid * 1024u;
    const int aoff = lds_byte(wr * 64 + fr, fq * 8), boff = lds_byte(wc * 32 + fr, fq * 8);
#define PG8_SA(b, h) (((b) * 2 + (h)) * HTB)
#define PG8_SB(b, h) ((4 + (b) * 2 + (h)) * HTB)
#define PG8_STAGE(bufoff, gbase, voff) do { _Pragma("unroll") for (int _i = 0; _i < 2; ++_i) \
        __builtin_amdgcn_global_load_lds((const unsigned*)((const char*)(gbase) + (voff)[_i]), (PG8_LAS unsigned*)(lds + (bufoff) + ldsw + _i * 8192), 16, 0, 0); } while (0)
#define PG8_LDA(dst, b, h) do { _Pragma("unroll") for (int m = 0; m < 4; ++m) _Pragma("unroll") for (int k = 0; k < 2; ++k) dst[m][k] = *(const PG8_LAS bf16x8*)(lds + PG8_SA(b, h) + aoff + m * 2048 + k * 1024); } while (0)
#define PG8_LDB(dst, b, h) do { _Pragma("unroll") for (int n = 0; n < 2; ++n) _Pragma("unroll") for (int k = 0; k < 2; ++k) dst[n][k] = *(const PG8_LAS bf16x8*)(lds + PG8_SB(b, h) + boff + n * 2048 + k * 1024); } while (0)
#define PG8_MMA(ai, bj, At, Bt) do { __builtin_amdgcn_s_setprio(1); _Pragma("unroll") for (int m = 0; m < 4; ++m) _Pragma("unroll") for (int n = 0; n < 2; ++n) _Pragma("unroll") for (int k = 0; k < 2; ++k) \
        acc[ai][bj][m][n] = __builtin_amdgcn_mfma_f32_16x16x32_bf16(Bt[n][k], At[m][k], acc[ai][bj][m][n], 0, 0, 0); __builtin_amdgcn_s_setprio(0); } while (0)
#define PG8_WAIT_V(n) asm volatile("s_waitcnt vmcnt(" #n ")" ::: "memory")
#define PG8_WAIT_L(n) asm volatile("s_waitcnt lgkmcnt(" #n ")" ::: "memory")
#define PG8_BAR __builtin_amdgcn_s_barrier()
#define PG8_SCHED __builtin_amdgcn_sched_barrier(0)
    Unit cur, nxt; int ui = 0;
    if (!S.next(0, cur)) return;
    f32x4 acc[2][2][4][2];
#pragma unroll
    for (int a = 0; a < 2; ++a)
#pragma unroll
        for (int b = 0; b < 2; ++b)
#pragma unroll
            for (int m = 0; m < 4; ++m)
#pragma unroll
                for (int n = 0; n < 2; ++n) acc[a][b][m][n] = (f32x4){0.f, 0.f, 0.f, 0.f};
    bf16x8 At[4][2], B0[2][2], B1[2][2];
    const char* cA = (const char*)g.A + (size_t)cur.pm * tstep; const char* cB = (const char*)g.Bt + (size_t)cur.pn * tstep;
    S.a_ready(cur); E.prefetch(aux, cur, 0, wid, lane);
    if constexpr (SP2) {
        PG8_STAGE(PG8_SB(0, 0), cB, voffB); PG8_STAGE(PG8_SB(0, 1), cB + hstep, voffB); PG8_STAGE(PG8_SA(0, 0), cA, voffA); PG8_STAGE(PG8_SA(0, 1), cA + hstep, voffA);
        if (wr == 1) PG8_BAR;
        PG8_WAIT_V(2); PG8_BAR;
        PG8_STAGE(PG8_SB(1, 0), cB + kstep, voffB); PG8_STAGE(PG8_SA(1, 0), cA + kstep, voffA); PG8_STAGE(PG8_SB(1, 1), cB + hstep + kstep, voffB);
        PG8_WAIT_V(6); PG8_BAR;
    } else {
        PG8_STAGE(PG8_SB(0, 0), cB, voffB); PG8_STAGE(PG8_SA(0, 0), cA, voffA); PG8_STAGE(PG8_SB(0, 1), cB + hstep, voffB); PG8_STAGE(PG8_SA(0, 1), cA + hstep, voffA);
        if (wr == 1) PG8_BAR;
        PG8_WAIT_V(4); PG8_BAR;
        PG8_STAGE(PG8_SB(1, 0), cB + kstep, voffB); PG8_STAGE(PG8_SA(1, 0), cA + kstep, voffA); PG8_STAGE(PG8_SB(1, 1), cB + hstep + kstep, voffB);
        PG8_WAIT_V(6); PG8_BAR;
    }
    for (;;) {
        const bool has_next = S.next(ui + 1, nxt);
        const char* nA = has_next ? (const char*)g.A + (size_t)nxt.pm * tstep : cA; const char* nB = has_next ? (const char*)g.Bt + (size_t)nxt.pn * tstep : cB;
        for (int t = 0; t < nt; t += 2) {
            const bool last = (t == nt - 2);
            const char* a1 = cA + (size_t)(t + 1) * kstep;
            const char* a2 = last ? nA : cA + (size_t)(t + 2) * kstep; const char* b2 = last ? nB : cB + (size_t)(t + 2) * kstep;
            const char* a3 = a2 + kstep; const char* b3 = b2 + kstep;
            if (last && has_next) { S.a_ready(nxt); E.prefetch(aux, nxt, ui + 1, wid, lane); }
            if constexpr (SP2) {
            PG8_LDB(B0, 0, 0); PG8_LDB(B1, 0, 1); PG8_SCHED; PG8_LDA(At, 0, 0); PG8_STAGE(PG8_SA(1, 1), a1 + hstep, voffA);
            PG8_WAIT_V(8); PG8_WAIT_L(0); PG8_BAR; PG8_MMA(0, 0, At, B0); PG8_MMA(0, 1, At, B1); PG8_BAR; PG8_SCHED;
            PG8_LDA(At, 0, 1); PG8_STAGE(PG8_SB(0, 0), b2, voffB); PG8_STAGE(PG8_SB(0, 1), b2 + hstep, voffB); PG8_STAGE(PG8_SA(0, 0), a2, voffA);
            PG8_WAIT_V(8); PG8_WAIT_L(0); PG8_BAR; PG8_MMA(1, 0, At, B0); PG8_MMA(1, 1, At, B1); PG8_BAR; PG8_SCHED;
            PG8_LDB(B0, 1, 0); PG8_LDB(B1, 1, 1); PG8_SCHED; PG8_LDA(At, 1, 0); PG8_STAGE(PG8_SA(0, 1), a2 + hstep, voffA);
            PG8_WAIT_V(8); PG8_WAIT_L(0); PG8_BAR; PG8_MMA(0, 0, At, B0); PG8_MMA(0, 1, At, B1); PG8_BAR; PG8_SCHED;
            PG8_LDA(At, 1, 1); PG8_STAGE(PG8_SB(1, 0), b3, voffB); PG8_STAGE(PG8_SB(1, 1), b3 + hstep, voffB); PG8_STAGE(PG8_SA(1, 0), a3, voffA);
            PG8_WAIT_V(8); PG8_WAIT_L(0); PG8_BAR; PG8_MMA(1, 0, At, B0); PG8_MMA(1, 1, At, B1); PG8_BAR; PG8_SCHED;
            } else {
            PG8_LDB(B0, 0, 0); PG8_SCHED; PG8_LDA(At, 0, 0); PG8_STAGE(PG8_SA(1, 1), a1 + hstep, voffA);
            PG8_WAIT_L(8); PG8_BAR; PG8_WAIT_L(0); PG8_MMA(0, 0, At, B0); PG8_BAR; PG8_SCHED;
            PG8_LDB(B1, 0, 1); PG8_STAGE(PG8_SB(0, 0), b2, voffB);
            PG8_BAR; PG8_WAIT_L(0); PG8_MMA(0, 1, At, B1); PG8_BAR;
            PG8_LDA(At, 0, 1); PG8_STAGE(PG8_SA(0, 0), a2, voffA);
            PG8_BAR; PG8_WAIT_L(0); PG8_MMA(1, 0, At, B0); PG8_BAR; PG8_SCHED;
            PG8_STAGE(PG8_SB(0, 1), b2 + hstep, voffB);
            PG8_WAIT_V(6); PG8_BAR; PG8_MMA(1, 1, At, B1); PG8_BAR;
            PG8_LDB(B0, 1, 0); PG8_SCHED; PG8_LDA(At, 1, 0); PG8_STAGE(PG8_SA(0, 1), a2 + hstep, voffA);
            PG8_WAIT_L(8); PG8_BAR; PG8_WAIT_L(0); PG8_MMA(0, 0, At, B0); PG8_BAR; PG8_SCHED;
            PG8_LDB(B1, 1, 1); PG8_STAGE(PG8_SB(1, 0), b3, voffB);
            PG8_BAR; PG8_WAIT_L(0); PG8_MMA(0, 1, At, B1); PG8_BAR;
            PG8_LDA(At, 1, 1); PG8_STAGE(PG8_SA(1, 0), a3, voffA);
            PG8_BAR; PG8_WAIT_L(0); PG8_MMA(1, 0, At, B0); PG8_BAR; PG8_SCHED;
            PG8_STAGE(PG8_SB(1, 1), b3 + hstep, voffB);
            PG8_WAIT_V(6); PG8_BAR; PG8_MMA(1, 1, At, B1); PG8_BAR;
            }
        }
        if constexpr (ALIGN_EPI) { if (wr == 0) PG8_BAR; }
        if constexpr (!Epi::AFTER_DRAIN) { E(acc, cur, wr, wc, fr, fq, aux, ui); S.done(cur); }
        if (!has_next) break;
#pragma unroll
        for (int a = 0; a < 2; ++a)
#pragma unroll
            for (int b = 0; b < 2; ++b)
#pragma unroll
                for (int m = 0; m < 4; ++m)
#pragma unroll
                    for (int n = 0; n < 2; ++n) acc[a][b][m][n] = (f32x4){0.f, 0.f, 0.f, 0.f};
        cur = nxt; cA = nA; cB = nB; ++ui;
        if constexpr (ALIGN_EPI) { if (wr == 1) PG8_BAR; }
    }
    PG8_WAIT_V(0);
    if constexpr (!ALIGN_EPI) { if (wr == 0) PG8_BAR; }
    PG8_BAR;
    if constexpr (Epi::AFTER_DRAIN) { E.fused(acc, cur, wr, wc, fr, fq, lds, wid, lane); S.done(cur); }
#undef PG8_SA
#undef PG8_SB
#undef PG8_STAGE
#undef PG8_LDA
#undef PG8_LDB
#undef PG8_MMA
#undef PG8_WAIT_V
#undef PG8_WAIT_L
#undef PG8_BAR
#undef PG8_SCHED
}
}
#define GAS __attribute__((address_space(1)))
#define LAS __attribute__((address_space(3)))
typedef unsigned short bf16;
typedef unsigned v4u __attribute__((ext_vector_type(4)));
typedef float f32x4 __attribute__((ext_vector_type(4)));
typedef short bf16x8 __attribute__((ext_vector_type(8)));
typedef GAS unsigned gu32;
typedef GAS unsigned long long gu64;
#define RLX_AGENT __ATOMIC_RELAXED, __HIP_MEMORY_SCOPE_AGENT
#define LDS_WAIT() asm volatile("s_waitcnt lgkmcnt(0)" ::: "memory")
#define VM_WAIT() asm volatile("s_waitcnt vmcnt(0)" ::: "memory")
__device__ __forceinline__ unsigned long long rt() { return __builtin_amdgcn_s_memrealtime(); }
__device__ __forceinline__ unsigned f2bf(float f) { unsigned u = __builtin_bit_cast(unsigned, f); return (u + 0x7fffu + ((u >> 16) & 1u)) >> 16; }
__device__ __forceinline__ unsigned pk2(float lo, float hi) { return f2bf(lo) | (f2bf(hi) << 16); }

#define XB_TMO      128
#define XB_XCNT(j)  (256  + 64 * (j))
#define XB_XSUB(j)  (1280 + 64 * (j))
#define XB_XGEN(j)  (2304 + 64 * (j))
#define XB_TOP      3328
#define XB_TOPGEN   3392
#define XCD_BAR_WORDS 3456
#define XB_SPIN_CAP (1u << 18)

__device__ __forceinline__ unsigned xb_ld(unsigned* p)              { return __hip_atomic_load(p, __ATOMIC_RELAXED, __HIP_MEMORY_SCOPE_AGENT); }
__device__ __forceinline__ unsigned xb_add(unsigned* p, unsigned v) { return __hip_atomic_fetch_add(p, v, __ATOMIC_RELAXED, __HIP_MEMORY_SCOPE_AGENT); }
__device__ __forceinline__ unsigned xb_xcc_id() { return (unsigned)__builtin_amdgcn_s_getreg((3 << 11) | 20) & 0xFu; }
#define XB_SPIN(cond, bar) do { unsigned _sp = 0; while (cond) { __builtin_amdgcn_s_sleep(1); \
    if ((++_sp & 255u) == 0u) { if (xb_ld(&(bar)[XB_TMO])) break; if (_sp > XB_SPIN_CAP) { atomicAdd(&(bar)[XB_TMO], 1u); break; } } } } while (0)

struct XcdBarrier {
    unsigned* bar; unsigned x;
    volatile LAS unsigned* st;
};

__device__ __forceinline__ XcdBarrier xcd_barrier_post(unsigned* bar, volatile LAS unsigned* st) {
    XcdBarrier b; b.bar = bar; b.x = xb_xcc_id(); b.st = st;
    if (threadIdx.x == 0) (void)xb_add(&bar[XB_XCNT(b.x)], 1u);
    return b;
}
__device__ __forceinline__ void xcd_barrier_complete(unsigned* bar, unsigned x, unsigned& nloc, unsigned& nx) {
    const unsigned G = gridDim.x * gridDim.y * gridDim.z;
    unsigned sum, cnt, mine, sp = 0u;
    for (;;) {
        sum = 0u; cnt = 0u; mine = 0u;
#pragma unroll
        for (unsigned j = 0; j < 16; ++j) { const unsigned c = xb_ld(&bar[XB_XCNT(j)]); sum += c; cnt += (c > 0u) ? 1u : 0u; mine = (j == x) ? c : mine; }
        if (sum == G) break;
        __builtin_amdgcn_s_sleep(1);
        if ((++sp & 255u) == 0u) { if (xb_ld(&bar[XB_TMO])) break; if (sp > XB_SPIN_CAP) { atomicAdd(&bar[XB_TMO], 1u); break; } }
    }
    nloc = mine > 0u ? mine : 1u; nx = cnt > 0u ? cnt : 1u;
}

__device__ __forceinline__ void xcd_barrier(const XcdBarrier& b) {
    asm volatile("s_waitcnt vmcnt(0)" ::: "memory");
    __syncthreads();
    if (threadIdx.x == 0) {
        unsigned* bar = b.bar;
        __builtin_amdgcn_s_waitcnt(0);
        unsigned nloc = b.st[0], nx = b.st[1];
        if (nloc == 0u) { xcd_barrier_complete(bar, b.x, nloc, nx); b.st[0] = nloc; b.st[1] = nx; }
        const unsigned old = xb_add(&bar[XB_XSUB(b.x)], 1u);
        const unsigned gen = old / nloc;
        if (old + 1u == (gen + 1u) * nloc) {
            __builtin_amdgcn_fence(__ATOMIC_RELEASE, "agent");
            asm volatile("s_waitcnt vmcnt(0)" ::: "memory");
            const unsigned og = xb_add(&bar[XB_TOP], 1u);
            const unsigned tg = og / nx;
            if (og + 1u == (tg + 1u) * nx) xb_add(&bar[XB_TOPGEN], 1u);
            else XB_SPIN(xb_ld(&bar[XB_TOPGEN]) == tg, bar);
            __builtin_amdgcn_fence(__ATOMIC_ACQUIRE, "agent");
            xb_add(&bar[XB_XGEN(b.x)], 1u);
            asm volatile("s_waitcnt vmcnt(0)" ::: "memory");
        } else {
            XB_SPIN(xb_ld(&bar[XB_XGEN(b.x)]) == gen, bar);
            __builtin_amdgcn_fence(__ATOMIC_ACQUIRE, "agent");
            asm volatile("s_waitcnt vmcnt(0)" ::: "memory");
        }
    }
    __syncthreads();
}
namespace moba_body {
typedef unsigned short bf16;
using bf16x8=__attribute__((ext_vector_type(8)))short;
using s16x4=__attribute__((ext_vector_type(4)))short;
using f32x16=__attribute__((ext_vector_type(16)))float;
using f32x4=__attribute__((ext_vector_type(4)))float;
using u32x4=__attribute__((ext_vector_type(4)))unsigned;
#define MB_GAS __attribute__((address_space(1)))
#define MB_LAS __attribute__((address_space(3)))
constexpr int D=64,NHEAD=4,PITCH=NPROJ,YPITCH=DM;
constexpr int NW=8,QBLK=32,QB=QBLK*NW,KVBLK=64,NQB=SEQ/QB;
__device__ __forceinline__ int crow(int r,int hi){return (r&3)+8*(r>>2)+4*hi;}
#define SBAR() __builtin_amdgcn_sched_barrier(0)
__device__ __forceinline__ void cmask(f32x16&p0,f32x16&p1,int jb,int qrel,int hi){
  const float NEG=-INFINITY; int kb=64*jb+4*hi;
  #pragma unroll
  for(int r=0;r<16;++r){int kv=kb+(r&3)+8*(r>>2); if(kv>qrel)p0[r]=NEG; if(kv+32>qrel)p1[r]=NEG;}
}
constexpr int NSLOT=3, SLOTB=8192;
constexpr int LDS_K=0, LDS_V=NSLOT*SLOTB, LDS_WS=2*NSLOT*SLOTB, LDS_OST=LDS_WS+NW*64*4, LDS_BYTES=LDS_OST+NW*4096;
constexpr float LOG2E=1.4426950408889634f;
__device__ __forceinline__ void glds16(const void*gsrc,unsigned lds_dst){unsigned keep;
  asm volatile("s_mov_b32 %0, m0\n\ts_mov_b32 m0, %2\n\ts_nop 0\n\tglobal_load_lds_dwordx4 %1, off\n\ts_mov_b32 m0, %0":"=&s"(keep):"v"(gsrc),"s"(lds_dst):"memory");}
typedef float f32x2_t __attribute__((ext_vector_type(2))); typedef __bf16 bf16x2_t __attribute__((ext_vector_type(2)));
__device__ __forceinline__ unsigned cvtpk_s(float lo,float hi){f32x2_t v={lo,hi};bf16x2_t b=__builtin_convertvector(v,bf16x2_t);return __builtin_bit_cast(unsigned,b);}
__device__ __forceinline__ float bfround(float x){ return __uint_as_float(cvtpk_s(x,0.f)<<16); }
#define WAIT_BAR(N) asm volatile("s_waitcnt vmcnt(" #N ") lgkmcnt(0)\n\ts_barrier":::"memory")
#define MFMA32(a,b,c) __builtin_amdgcn_mfma_f32_32x32x16_bf16(a,b,c,0,0,0)
typedef __attribute__((address_space(3))) const char* lds_cptr;
typedef short v4i16_t __attribute__((ext_vector_type(4)));
__device__ __forceinline__ void kload8(bf16x8*kf,lds_cptr kp){
  kf[0]=*(const __attribute__((address_space(3))) bf16x8*)(kp);      kf[1]=*(const __attribute__((address_space(3))) bf16x8*)(kp+512);
  kf[2]=*(const __attribute__((address_space(3))) bf16x8*)(kp+2048); kf[3]=*(const __attribute__((address_space(3))) bf16x8*)(kp+2560);
  kf[4]=*(const __attribute__((address_space(3))) bf16x8*)(kp+4096); kf[5]=*(const __attribute__((address_space(3))) bf16x8*)(kp+4608);
  kf[6]=*(const __attribute__((address_space(3))) bf16x8*)(kp+6144); kf[7]=*(const __attribute__((address_space(3))) bf16x8*)(kp+6656);
}
__device__ __forceinline__ void kload2(bf16x8*kf,lds_cptr kp,int j){ kf[2*j]=*(const __attribute__((address_space(3))) bf16x8*)(kp+j*2048); kf[2*j+1]=*(const __attribute__((address_space(3))) bf16x8*)(kp+j*2048+512); }
__device__ __forceinline__ s16x4 vtr(lds_cptr p){ return __builtin_bit_cast(s16x4,__builtin_amdgcn_ds_read_tr16_b64_v4i16((__attribute__((address_space(3))) v4i16_t*)p)); }
#define MX3(a,b,c) __builtin_fmaxf(__builtin_fmaxf((a),(b)),(c))
__device__ __forceinline__ float rowmax(const f32x16&p0,const f32x16&p1){
  float a=MX3(p0[0],p0[1],p1[0]),b=MX3(p0[2],p0[3],p1[1]);a=MX3(a,p1[2],p1[3]);
  #pragma unroll
  for(int r=4;r<16;r+=4){a=MX3(a,p0[r],p0[r+1]);b=MX3(b,p0[r+2],p0[r+3]);a=MX3(a,p1[r],p1[r+1]);b=MX3(b,p1[r+2],p1[r+3]);}
  const float m=__builtin_fmaxf(a,b);
  auto rr=__builtin_amdgcn_permlane32_swap(__float_as_uint(m),__float_as_uint(m),false,false);
  return __builtin_fmaxf(__uint_as_float(rr[0]),__uint_as_float(rr[1]));
}
__device__ __forceinline__ void pv(f32x16*o,int vb,bf16x8 pa0,bf16x8 pa1,bf16x8 pa2,bf16x8 pa3){
  #pragma unroll
  for(int d0=0;d0<2;++d0){s16x4 lo[4],hi[4];
    #pragma unroll
    for(int ks=0;ks<4;++ks){
      asm volatile("ds_read_b64_tr_b16 %0,%1 offset:%c2":"=&v"(lo[ks]):"v"(vb),"i"(d0*4096+ks*1024):"memory");
      asm volatile("ds_read_b64_tr_b16 %0,%1 offset:%c2":"=&v"(hi[ks]):"v"(vb),"i"(d0*4096+ks*1024+512):"memory");}
    asm volatile("s_waitcnt lgkmcnt(0)":::"memory");SBAR();
    #define PK(k) (bf16x8){lo[k][0],lo[k][1],lo[k][2],lo[k][3],hi[k][0],hi[k][1],hi[k][2],hi[k][3]}
    o[d0]=MFMA32(pa0,PK(0),o[d0]);
    o[d0]=MFMA32(pa1,PK(1),o[d0]);
    o[d0]=MFMA32(pa2,PK(2),o[d0]);
    o[d0]=MFMA32(pa3,PK(3),o[d0]);
    #undef PK
  }
}
template<int NT,int MODE> __device__ __forceinline__ void chunk_attn(f32x16*o,float&l,const bf16x8*qr,u32x4&ka,const u32x4&qa0,const u32x4&qa1,unsigned hm,float dTb,lds_cptr kp0,lds_cptr vp0,int tile0,int r32,int hi,int qd){
  #define CK_SETDT(t) do{ const float d_=dTb+(float)(64*(tile0+(t))); ka[1]=cvtpk_s(d_,d_)&hm; }while(0)
  #define CK_KA __builtin_bit_cast(bf16x8,ka)
  #define CK_MASK(C0,C1,t) do{ if(MODE==1&&(t)==NT-1){ _Pragma("unroll") for(int r=0;r<16;++r){ const int kv=crow(r,hi); if(kv>qd)C0[r]=-INFINITY; if(kv+32>qd)C1[r]=-INFINITY; } } \
      if(MODE==2){ const int kb_=64*(tile0+(t)); _Pragma("unroll") for(int r=0;r<16;++r){ const int kk=kb_+crow(r,hi); if(kk>qd||kk<qd-127)C0[r]=-INFINITY; if(kk+32>qd||kk+32<qd-127)C1[r]=-INFINITY; } } }while(0)
  bf16x8 kf[8]; s16x4 vlo[8],vhi[8]; u32x4 pw0,pw1,pw2,pw3; f32x16 pA0,pA1,pB0,pB1;
  #define PKW(P,B) cvtpk_s(P[B],P[B+1])
  #define PAF(k) __builtin_bit_cast(bf16x8,pw##k)
  #define VFR(i) (bf16x8){vlo[i][0],vlo[i][1],vlo[i][2],vlo[i][3],vhi[i][0],vhi[i][1],vhi[i][2],vhi[i][3]}
  #define PIN(x) asm volatile("":"+v"(x))
  #define GAPA(MF,A0,A1,A2,A3,W0,W1,PW) do{ MF; sacc+=A0; sacc+=A1; sacc+=A2; sacc+=A3; PIN(sacc); W0; W1; PIN(PW); SBAR(); }while(0)
  #define EX(v) __builtin_amdgcn_exp2f(v)
  #define GAPB(MF,X,B) do{ MF; X[B]=EX(X[B]); X[B+1]=EX(X[B+1]); X[B+2]=EX(X[B+2]); X[B+3]=EX(X[B+3]); PIN(X); SBAR(); }while(0)
  #define VRD(i) do{ vlo[i]=vtr(vp_+(((i)>>2)*4096+((i)&3)*1024)); vhi[i]=vtr(vp_+(((i)>>2)*4096+((i)&3)*1024+512)); }while(0)
  #define KRD(G,t,j) do{ if(G){ kload2(kf,kp0+(tile0+(t)+1)*SLOTB,j); SBAR(); } }while(0)
  #define CK_STEP(C0,C1,P0,P1,t,GL) do{ SBAR(); \
    const lds_cptr vp_=vp0+(tile0+(t)-1)*SLOTB; CK_SETDT(t); \
    C0=MFMA32(CK_KA,__builtin_bit_cast(bf16x8,qa0),f32x16{}); C1=MFMA32(CK_KA,__builtin_bit_cast(bf16x8,qa1),f32x16{}); SBAR(); \
    VRD(0); SBAR(); float sacc=(P0[0]+P0[1]); \
    GAPA(C0=MFMA32(kf[0],qr[0],C0), P0[2],P0[3],P0[4],P0[5],     pw0[0]=PKW(P0,0), pw0[1]=PKW(P0,2), pw0); \
    VRD(4); SBAR(); GAPA(C1=MFMA32(kf[1],qr[0],C1), P0[6],P0[7],P0[8],P0[9],     pw0[2]=PKW(P0,4), pw0[3]=PKW(P0,6), pw0); \
    VRD(1); SBAR(); GAPA(C0=MFMA32(kf[2],qr[1],C0),   P0[10],P0[11],P0[12],P0[13], pw1[0]=PKW(P0,8), pw1[1]=PKW(P0,10), pw1); \
    VRD(5); SBAR(); GAPA(C1=MFMA32(kf[3],qr[1],C1),   P0[14],P0[15],P1[0],P1[1],   pw1[2]=PKW(P0,12),pw1[3]=PKW(P0,14), pw1); \
    VRD(2); SBAR(); GAPA(C0=MFMA32(kf[4],qr[2],C0),   P1[2],P1[3],P1[4],P1[5],     pw2[0]=PKW(P1,0), pw2[1]=PKW(P1,2), pw2); \
    VRD(6); SBAR(); GAPA(C1=MFMA32(kf[5],qr[2],C1),   P1[6],P1[7],P1[8],P1[9],     pw2[2]=PKW(P1,4), pw2[3]=PKW(P1,6), pw2); \
    VRD(3); SBAR(); GAPA(C0=MFMA32(kf[6],qr[3],C0),   P1[10],P1[11],P1[12],P1[13], pw3[0]=PKW(P1,8), pw3[1]=PKW(P1,10), pw3); \
    VRD(7); SBAR(); GAPA(C1=MFMA32(kf[7],qr[3],C1),   P1[14],P1[15],0.f,0.f,       pw3[2]=PKW(P1,12),pw3[3]=PKW(P1,14), pw3); \
    l+=sacc; \
    CK_MASK(C0,C1,t); \
    SBAR(); \
    GAPB(o[0]=MFMA32(PAF(0),VFR(0),o[0]), C0,0); \
    GAPB(o[1]=MFMA32(PAF(0),VFR(4),o[1]), C0,4); \
    KRD(GL,t,0); GAPB(o[0]=MFMA32(PAF(1),VFR(1),o[0]), C0,8); \
    KRD(GL,t,1); GAPB(o[1]=MFMA32(PAF(1),VFR(5),o[1]), C0,12); \
    KRD(GL,t,2); GAPB(o[0]=MFMA32(PAF(2),VFR(2),o[0]), C1,0); \
    KRD(GL,t,3); GAPB(o[1]=MFMA32(PAF(2),VFR(6),o[1]), C1,4); \
    GAPB(o[0]=MFMA32(PAF(3),VFR(3),o[0]), C1,8); \
    GAPB(o[1]=MFMA32(PAF(3),VFR(7),o[1]), C1,12); \
    }while(0)
  #define CK_DRAIN(P0,P1,t) do{ float sacc=P0[0]+P0[1]; _Pragma("unroll") for(int r=2;r<16;++r)sacc+=P0[r]; _Pragma("unroll") for(int r=0;r<16;++r)sacc+=P1[r]; l+=sacc; \
    pw0=(u32x4){PKW(P0,0),PKW(P0,2),PKW(P0,4),PKW(P0,6)};pw1=(u32x4){PKW(P0,8),PKW(P0,10),PKW(P0,12),PKW(P0,14)};pw2=(u32x4){PKW(P1,0),PKW(P1,2),PKW(P1,4),PKW(P1,6)};pw3=(u32x4){PKW(P1,8),PKW(P1,10),PKW(P1,12),PKW(P1,14)}; \
    const lds_cptr vp_=vp0+(tile0+(t))*SLOTB; _Pragma("unroll") for(int i=0;i<8;++i)VRD(i); \
    o[0]=MFMA32(PAF(0),VFR(0),o[0]); o[1]=MFMA32(PAF(0),VFR(4),o[1]); o[0]=MFMA32(PAF(1),VFR(1),o[0]); o[1]=MFMA32(PAF(1),VFR(5),o[1]); \
    o[0]=MFMA32(PAF(2),VFR(2),o[0]); o[1]=MFMA32(PAF(2),VFR(6),o[1]); o[0]=MFMA32(PAF(3),VFR(3),o[0]); o[1]=MFMA32(PAF(3),VFR(7),o[1]); }while(0)
  CK_SETDT(0); kload8(kf,kp0+tile0*SLOTB);
  pA0=MFMA32(CK_KA,__builtin_bit_cast(bf16x8,qa0),f32x16{}); pA1=MFMA32(CK_KA,__builtin_bit_cast(bf16x8,qa1),f32x16{});
  #pragma unroll
  for(int d0=0;d0<4;++d0){ pA0=MFMA32(kf[2*d0],qr[d0],pA0); pA1=MFMA32(kf[2*d0+1],qr[d0],pA1); }
  CK_MASK(pA0,pA1,0);
  if(NT>1){ SBAR(); kload8(kf,kp0+(tile0+1)*SLOTB); }
  #pragma unroll
  for(int r=0;r<16;++r){ pA0[r]=EX(pA0[r]); pA1[r]=EX(pA1[r]); }
  if(NT>1){ CK_STEP(pB0,pB1,pA0,pA1,1,(NT>2)); }
  if(NT>2){ CK_STEP(pA0,pA1,pB0,pB1,2,(NT>3)); }
  if(NT>3){ CK_STEP(pB0,pB1,pA0,pA1,3,false); }
  if(NT==1||NT==3){ CK_DRAIN(pA0,pA1,NT-1); } else { CK_DRAIN(pB0,pB1,NT-1); }
  #undef CK_SETDT
  #undef CK_KA
  #undef CK_MASK
  #undef PKW
  #undef PAF
  #undef VFR
  #undef PIN
  #undef GAPA
  #undef EX
  #undef GAPB
  #undef VRD
  #undef KRD
  #undef CK_STEP
  #undef CK_DRAIN
}
constexpr int GS_QP=0, GS_TJ=4352, GS_PRE=4480, GS_RNG=4736, GS_WSF=4864, GS_DST=6912, GS_STG=8192, GS_C=17408, GS_BYTES=21504;
constexpr int STG_LD=72;
__device__ __forceinline__ u32x4 stage8(const f32x16*o,const MB_LAS float*wsf,MB_LAS bf16*stg,int k,int lane,int r32,int hi){
  #pragma unroll
  for(int rr=0;rr<4;++rr){ const int r=4*k+rr, lrow=rr+4*hi; const float ri=wsf[32+crow(r,hi)];
    #pragma unroll
    for(int d0=0;d0<2;++d0)stg[lrow*STG_LD+d0*32+r32]=(bf16)(cvtpk_s(o[d0][r]*ri,0.f)&0xffffu);}
  asm volatile("s_waitcnt lgkmcnt(0)":::"memory");
  const u32x4 v=*(const MB_LAS u32x4*)(stg+(lane>>3)*STG_LD+(lane&7)*8);
  asm volatile("s_waitcnt lgkmcnt(0)":::"memory");
  return v;
}
__device__ __forceinline__ void swa_phase(char*shm,char*scr,const bf16*P,const float*sinks,bf16*Y,int vcu,int G){
  int tid_=threadIdx.x; asm volatile("":"+v"(tid_));
  const int tid=tid_,lane=tid&63,r32=lane&31,hi=lane>>5; const int wid=__builtin_amdgcn_readfirstlane(tid>>6);
  const int g=wid>>2,qs=32*(wid&3),tl=(qs>=64)?1:0;
  const unsigned lds0=(unsigned)(uintptr_t)shm;
  MB_LAS float*wsf=(MB_LAS float*)(scr+GS_WSF)+wid*64; MB_LAS bf16*stg=(MB_LAS bf16*)(scr+GS_STG)+wid*(8*STG_LD);
  const lds_cptr shm3=(lds_cptr)shm; const lds_cptr vp0=shm3+4*SLOTB+((lane>>4)&1)*32+(lane&3)*8+(4*hi+((lane&15)>>2))*64; const lds_cptr kp0=shm3+hi*1024+r32*16;
  const unsigned kdst=lds0+wid*1024, vdst=lds0+4*SLOTB+wid*1024;
  const unsigned hm=hi?0u:0xffffffffu; const float Lh=bfround(LOG2E),Ll=bfround(LOG2E-Lh);
  const int NU=NB*2*(SEQ/128);
  #define SWA_DMA(U,BUF) do{ const int n_=(U)&63,kv_=((U)>>6)&1,b_=(U)>>7; const long key0_=128L*(n_-1); const int tf_=(n_==0)?2:0; \
      const bf16*ks_=P+OFF_KC+((size_t)(b_*2+kv_)*SEQ+key0_+lane)*64+wid*8; const bf16*vs_=P+OFF_VC+((size_t)(b_*2+kv_)*SEQ+key0_+16*(wid&3)+(lane>>2))*64+(wid>>2)*32+(lane&3)*8; \
      _Pragma("unroll") for(int t=0;t<4;++t) if(t>=tf_){ glds16(ks_+(long)t*KVBLK*64,(unsigned)__builtin_amdgcn_readfirstlane(kdst+(BUF)*65536+t*SLOTB)); glds16(vs_+(long)t*KVBLK*64,(unsigned)__builtin_amdgcn_readfirstlane(vdst+(BUF)*65536+t*SLOTB)); } }while(0)
  #define SWA_Q(U,QO) do{ const int n_=(U)&63,kv_=((U)>>6)&1,b_=(U)>>7; const bf16*Qw_=P+OFF_QC+((size_t)(b_*4+kv_*2+g)*SEQ+128L*n_+qs+r32)*64+hi*8; _Pragma("unroll") for(int d0=0;d0<4;++d0)QO[d0]=*(const MB_GAS bf16x8*)(Qw_+d0*16); }while(0)
  bf16x8 qr[4],qn[4]; int u=vcu,buf=0;
  if(u<NU){ SWA_DMA(u,0); SWA_Q(u,qr); }
  #pragma unroll 1
  for(;u<NU;u+=G){
    WAIT_BAR(0);
    if(u+G<NU){ SWA_DMA(u+G,buf^1); }
    const int n=u&63,kv=(u>>6)&1,b=u>>7,hq=kv*2+g;
    const float slope=__builtin_amdgcn_exp2f(-(float)(1+hq));
    const unsigned w_A=cvtpk_s(slope*Lh,slope*Ll)&hm, w_32A=cvtpk_s(32.f*slope*Lh,32.f*slope*Ll)&hm;
    const int qq=128+qs+r32;
    const float crow_x=-(slope*LOG2E)*(float)qq, crow_c=bfround(crow_x), crow_d=crow_c-crow_x;
    u32x4 ka,qa0,qa1;
    { const unsigned jw=cvtpk_s((float)r32,(float)r32)&hm; ka[0]=jw; ka[1]=0u; ka[2]=0x3f803f80u&hm; ka[3]=0x3f803f80u&hm;
      const unsigned wm=cvtpk_s(0.f,crow_c)&hm; qa0[0]=w_A;qa0[1]=w_A;qa0[2]=wm;qa0[3]=0u; qa1[0]=w_A;qa1[1]=w_A;qa1[2]=wm;qa1[3]=w_32A; }
    const size_t hrow=(size_t)(b*4+hq)*SEQ+128L*n+qs;
    u32x4 gt[4];
    #pragma unroll
    for(int k=0;k<4;++k) gt[k]=*(const MB_GAS u32x4*)(P+OFF_GC+(hrow+8*k+(lane>>3))*64+(lane&7)*8);
    f32x16 o[2]; o[0]=f32x16{}; o[1]=f32x16{}; float l=0.f;
    const lds_cptr kpb=kp0+buf*65536, vpb=vp0+buf*65536;
    if(n==0){ if(tl) chunk_attn<2,2>(o,l,qr,ka,qa0,qa1,hm,0.f,kpb,vpb,2,r32,hi,qq); else chunk_attn<1,2>(o,l,qr,ka,qa0,qa1,hm,0.f,kpb,vpb,2,r32,hi,qq); }
    else chunk_attn<3,2>(o,l,qr,ka,qa0,qa1,hm,0.f,kpb,vpb,tl,r32,hi,qq);
    if(u+G<NU){ SWA_Q(u+G,qn); }
    { auto rr=__builtin_amdgcn_permlane32_swap(__float_as_uint(l),__float_as_uint(l),false,false); l=__uint_as_float(rr[0])+__uint_as_float(rr[1]); }
    l+=__builtin_amdgcn_exp2f(*(const MB_GAS float*)(sinks+hq)*LOG2E+crow_d);
    if(hi==0)wsf[32+r32]=__builtin_amdgcn_rcpf(l); asm volatile("s_waitcnt lgkmcnt(0)":::"memory");
    const size_t yrow=(size_t)b*SEQ+128L*n+qs;
    #pragma unroll
    for(int k=0;k<4;++k){ const u32x4 v=stage8(o,wsf,stg,k,lane,r32,hi); const u32x4 gg=gt[k]; u32x4 w;
      #pragma unroll
      for(int e=0;e<4;++e) w[e]=cvtpk_s(__uint_as_float(v[e]<<16)*__uint_as_float(gg[e]<<16),__uint_as_float(v[e]&0xffff0000u)*__uint_as_float(gg[e]&0xffff0000u));
      *(MB_GAS u32x4*)(Y+(yrow+8*k+(lane>>3))*YPITCH+512+hq*D+(lane&7)*8)=w; }
    #pragma unroll
    for(int d0=0;d0<4;++d0)qr[d0]=qn[d0];
    buf^=1;
  }
  #undef SWA_DMA
  #undef SWA_Q
  asm volatile("s_waitcnt vmcnt(0) lgkmcnt(0)\n\ts_barrier":::"memory");
}
constexpr int SP_LDS_C=65536, SP_LDS_WSF=65536+12288, SP_LDS_DST=SP_LDS_WSF+NW*256, SP_LDS_STG=SP_LDS_DST+NW*128, SP_LDS_BYTES=SP_LDS_STG+NW*4096;
typedef __attribute__((address_space(3))) unsigned lds_u32;
__device__ __forceinline__ void select_phase(char*scr,const bf16*P,const float*kmean,unsigned*cnt,unsigned short*lst,int vcu,int G){
  int tid_=threadIdx.x; asm volatile("":"+v"(tid_));
  const int tid=tid_,lane=tid&63,r32=lane&31,hi=lane>>5; const int wid=__builtin_amdgcn_readfirstlane(tid>>6);
  lds_u32*ldscnt=(lds_u32*)(scr+GS_C);
  const int qrel=wid*QBLK+r32;
  #pragma unroll 1
  for(int u=vcu;u<32*NQB;u+=G){
    const int bh=u>>5,qb=u&31;
    if(tid<32)ldscnt[tid]=0u;
    bf16x8 qr[4];
    #pragma unroll
    for(int d0=0;d0<4;++d0)qr[d0]=*(const MB_GAS bf16x8*)(&P[OFF_QA+((size_t)bh*SEQ+qb*QB+qrel)*64+d0*16+hi*8]);
    f32x16 bsc=f32x16{};
    const float*kmr=kmean+(size_t)bh*32*64+r32*64+hi*8;
    #pragma unroll
    for(int d0=0;d0<4;++d0){ const f32x4 a=*(const MB_GAS f32x4*)(kmr+d0*16), c=*(const MB_GAS f32x4*)(kmr+d0*16+4);
      const float x[8]={a[0],a[1],a[2],a[3],c[0],c[1],c[2],c[3]}; u32x4 hw,lw;
      #pragma unroll
      for(int i=0;i<4;++i){ const unsigned ph=cvtpk_s(x[2*i],x[2*i+1]); const float h0=__uint_as_float(ph<<16),h1=__uint_as_float(ph&0xffff0000u); hw[i]=ph; lw[i]=cvtpk_s(x[2*i]-h0,x[2*i+1]-h1); }
      bsc=MFMA32(__builtin_bit_cast(bf16x8,hw),qr[d0],bsc); bsc=MFMA32(__builtin_bit_cast(bf16x8,lw),qr[d0],bsc); }
    #pragma unroll
    for(int r=0;r<16;++r) if(crow(r,hi)>=qb) bsc[r]=-INFINITY;
    int wn[3]; bool wok[3];
    #pragma unroll
    for(int rd=0;rd<3;++rd){
      float bv=bsc[0]; int bi=crow(0,hi);
      #pragma unroll
      for(int r=1;r<16;++r){ if(bsc[r]>bv){bv=bsc[r];bi=crow(r,hi);} }
      auto sv=__builtin_amdgcn_permlane32_swap(__float_as_uint(bv),__float_as_uint(bv),false,false);
      auto si=__builtin_amdgcn_permlane32_swap((unsigned)bi,(unsigned)bi,false,false);
      const float v0=__uint_as_float(sv[0]),v1=__uint_as_float(sv[1]); const int i0=(int)si[0],i1=(int)si[1];
      const bool first=(v0>v1)||(v0==v1&&i0<i1); const float wv=first?v0:v1; wn[rd]=first?i0:i1; wok[rd]=wv>-INFINITY;
      #pragma unroll
      for(int r=0;r<16;++r) if(crow(r,hi)==wn[rd]) bsc[r]=-INFINITY;
    }
    asm volatile("s_waitcnt lgkmcnt(0)\n\ts_barrier":::"memory");
    #pragma unroll
    for(int rd=0;rd<3;++rd) if(wok[rd]&&hi==0){ const unsigned pos=__hip_atomic_fetch_add(ldscnt+wn[rd],1u,__ATOMIC_RELAXED,__HIP_MEMORY_SCOPE_WORKGROUP);
        *(MB_GAS unsigned short*)(lst+(((size_t)bh*32+wn[rd])*32+qb)*256+pos)=(unsigned short)((rd<<8)|qrel); }
    asm volatile("s_waitcnt lgkmcnt(0)\n\ts_barrier":::"memory");
    if(tid<32)*(MB_GAS unsigned*)(cnt+((size_t)bh*32+tid)*32+qb)=ldscnt[tid];
  }
  asm volatile("s_waitcnt lgkmcnt(0)\n\ts_barrier":::"memory");
}
__device__ __forceinline__ void own_merge_phase(char*shm,char*scr,const bf16*P,const bf16*partO,const float*partL,bf16*Y,int vcu,int G){
  int tid_=threadIdx.x; asm volatile("":"+v"(tid_));
  const int tid=tid_,lane=tid&63,r32=lane&31,hi=lane>>5; const int wid=__builtin_amdgcn_readfirstlane(tid>>6);
  const unsigned lds0=(unsigned)(uintptr_t)shm;
  MB_LAS float*wsf=(MB_LAS float*)(scr+GS_WSF)+wid*64; MB_LAS bf16*stg=(MB_LAS bf16*)(scr+GS_STG)+wid*(8*STG_LD);
  const lds_cptr shm3=(lds_cptr)shm; const lds_cptr vp0=shm3+4*SLOTB+((lane>>4)&1)*32+(lane&3)*8+(4*hi+((lane&15)>>2))*64; const lds_cptr kp0=shm3+hi*1024+r32*16;
  const unsigned kdst=lds0+wid*1024, vdst=lds0+4*SLOTB+wid*1024;
  const unsigned hm=hi?0u:0xffffffffu; const float Lh=bfround(LOG2E),Ll=bfround(LOG2E-Lh);
  const int qrel=wid*QBLK+r32, NU=32*NQB;
  #define OWN_DMA(U,BUF) do{ const int bh_=(U)>>5,qb_=(U)&31; const bf16*ks_=P+OFF_KA+((size_t)bh_*SEQ+qb_*QB+lane)*64+wid*8; const bf16*vs_=P+OFF_VA+((size_t)bh_*SEQ+qb_*QB+16*(wid&3)+(lane>>2))*64+(wid>>2)*32+(lane&3)*8; \
      _Pragma("unroll") for(int t=0;t<4;++t){ glds16(ks_+(long)t*KVBLK*64,(unsigned)__builtin_amdgcn_readfirstlane(kdst+(BUF)*65536+t*SLOTB)); glds16(vs_+(long)t*KVBLK*64,(unsigned)__builtin_amdgcn_readfirstlane(vdst+(BUF)*65536+t*SLOTB)); } }while(0)
  #define OWN_Q(U,QO) do{ const int bh_=(U)>>5,qb_=(U)&31; const bf16*Qw_=P+OFF_QA+((size_t)bh_*SEQ+qb_*QB+qrel)*64+hi*8; _Pragma("unroll") for(int d0=0;d0<4;++d0)QO[d0]=*(const MB_GAS bf16x8*)(Qw_+d0*16); }while(0)
  bf16x8 qr[4],qn[4]; int u=vcu,buf=0;
  if(u<NU){ OWN_DMA(u,0); OWN_Q(u,qr); }
  #pragma unroll 1
  for(;u<NU;u+=G){
    WAIT_BAR(0);
    if(u+G<NU){ OWN_DMA(u+G,buf^1); }
    const int bh=u>>5,qb=u&31,h=bh&3,b=bh>>2,nsel=qb<3?qb:3;
    const float slope=__builtin_amdgcn_exp2f(-(float)(5+h));
    const unsigned w_A=cvtpk_s(slope*Lh,slope*Ll)&hm, w_32A=cvtpk_s(32.f*slope*Lh,32.f*slope*Ll)&hm;
    const float crow_x=-(slope*LOG2E)*(float)qrel, crow_c=bfround(crow_x), crow_d=crow_c-crow_x;
    u32x4 ka,qa0,qa1;
    { const unsigned jw=cvtpk_s((float)r32,(float)r32)&hm; ka[0]=jw; ka[1]=0u; ka[2]=0x3f803f80u&hm; ka[3]=0x3f803f80u&hm;
      const unsigned wm=cvtpk_s(0.f,crow_c)&hm; qa0[0]=w_A;qa0[1]=w_A;qa0[2]=wm;qa0[3]=0u; qa1[0]=w_A;qa1[1]=w_A;qa1[2]=wm;qa1[3]=w_32A; }
    f32x16 o[2]; o[0]=f32x16{}; o[1]=f32x16{}; float l=0.f;
    const lds_cptr kpb=kp0+buf*65536, vpb=vp0+buf*65536; const int tlast=wid>>1, qd=qrel-64*tlast;
    if(tlast==0) chunk_attn<1,1>(o,l,qr,ka,qa0,qa1,hm,0.f,kpb,vpb,0,r32,hi,qd); else if(tlast==1) chunk_attn<2,1>(o,l,qr,ka,qa0,qa1,hm,0.f,kpb,vpb,0,r32,hi,qd);
    else if(tlast==2) chunk_attn<3,1>(o,l,qr,ka,qa0,qa1,hm,0.f,kpb,vpb,0,r32,hi,qd); else chunk_attn<4,1>(o,l,qr,ka,qa0,qa1,hm,0.f,kpb,vpb,0,r32,hi,qd);
    { auto rr=__builtin_amdgcn_permlane32_swap(__float_as_uint(l),__float_as_uint(l),false,false); l=__uint_as_float(rr[0])+__uint_as_float(rr[1]); }
    if(u+G<NU){ OWN_Q(u+G,qn); }
    const float sh=__builtin_amdgcn_exp2f(-crow_d);
    if(hi==0){ wsf[r32]=l*sh; wsf[32+r32]=sh; } asm volatile("s_waitcnt lgkmcnt(0)":::"memory");
    const size_t q0row=(size_t)bh*SEQ+qb*QB+wid*QBLK;
    f32x4 lv4[4]; u32x4 pp0[4],pp1[4],pp2[4],gg4[4];
    #pragma unroll
    for(int k=0;k<4;++k){ const int row=8*k+(lane>>3),ch=lane&7; const bf16*po=partO+(q0row+row)*256+ch*8;
      lv4[k]=*(const MB_GAS f32x4*)(partL+(q0row+row)*4);
      pp0[k]=(u32x4){0u,0u,0u,0u}; pp1[k]=pp0[k]; pp2[k]=pp0[k];
      if(nsel>0)pp0[k]=*(const MB_GAS u32x4*)(po); if(nsel>1)pp1[k]=*(const MB_GAS u32x4*)(po+64); if(nsel>2)pp2[k]=*(const MB_GAS u32x4*)(po+128);
      gg4[k]=*(const MB_GAS u32x4*)(P+OFF_GA+(q0row+row)*64+ch*8); }
    #pragma unroll
    for(int k=0;k<4;++k){ const int row=8*k+(lane>>3),ch=lane&7;
      const f32x4 lv=lv4[k]; const u32x4 p0=pp0[k],p1=pp1[k],p2=pp2[k],gg=gg4[k];
      const u32x4 v=stage8(o,wsf,stg,k,lane,r32,hi);
      const float l0=nsel>0?lv[0]:0.f,l1=nsel>1?lv[1]:0.f,l2=nsel>2?lv[2]:0.f; const float iw=__builtin_amdgcn_rcpf(wsf[row]+l0+l1+l2); u32x4 w;
      #pragma unroll
      for(int e=0;e<4;++e){ const float a0=__uint_as_float(v[e]<<16)+l0*__uint_as_float(p0[e]<<16)+l1*__uint_as_float(p1[e]<<16)+l2*__uint_as_float(p2[e]<<16);
        const float a1=__uint_as_float(v[e]&0xffff0000u)+l0*__uint_as_float(p0[e]&0xffff0000u)+l1*__uint_as_float(p1[e]&0xffff0000u)+l2*__uint_as_float(p2[e]&0xffff0000u);
        w[e]=cvtpk_s(a0*iw*__uint_as_float(gg[e]<<16),a1*iw*__uint_as_float(gg[e]&0xffff0000u)); }
      *(MB_GAS u32x4*)(Y+((size_t)b*SEQ+qb*QB+wid*QBLK+row)*YPITCH+h*D+ch*8)=w; }
    #pragma unroll
    for(int d0=0;d0<4;++d0)qr[d0]=qn[d0];
    buf^=1;
  }
  #undef OWN_DMA
  #undef OWN_Q
  asm volatile("s_waitcnt vmcnt(0) lgkmcnt(0)\n\ts_barrier":::"memory");
}
__device__ __forceinline__ void sp_store8(const f32x16*o,float linv_src,bf16*base,const MB_LAS int*dstl,MB_LAS float*wsf,MB_LAS bf16*stg,int lane,int r32,int hi){
  if(hi==0)wsf[32+r32]=linv_src; asm volatile("s_waitcnt lgkmcnt(0)":::"memory");
  #pragma unroll
  for(int k=0;k<4;++k){
    #pragma unroll
    for(int rr=0;rr<4;++rr){ const int r=4*k+rr, lrow=rr+4*hi; const float ri=wsf[32+crow(r,hi)];
      #pragma unroll
      for(int d0=0;d0<2;++d0)stg[lrow*STG_LD+d0*32+r32]=(bf16)(cvtpk_s(o[d0][r]*ri,0.f)&0xffffu);}
    asm volatile("s_waitcnt lgkmcnt(0)":::"memory");
    { const int lrow=lane>>3,ch=lane&7; const long d=dstl[8*k+lrow]; const u32x4 v=*(const MB_LAS u32x4*)(stg+lrow*STG_LD+ch*8); if(d>=0) *(MB_GAS u32x4*)(base+d+ch*8)=v; }
    asm volatile("s_waitcnt lgkmcnt(0)":::"memory");
  }
}
__device__ __forceinline__ void gather_phase(char*shm,char*scr,const bf16*P,const unsigned*cnt,const unsigned short*lst,bf16*partO,float*partL,int vcu){
  int tid_=threadIdx.x; asm volatile("":"+v"(tid_));
  const int tid=tid_,lane=tid&63,r32=lane&31,hi=lane>>5; const int wid=__builtin_amdgcn_readfirstlane(tid>>6);
  const int bh=vcu>>3,sv=vcu&7,b=bh>>2,h=bh&3; const long rowbase=(long)b*SEQ;
  const unsigned lds0=(unsigned)(uintptr_t)shm;
  volatile lds_u32*C=(volatile lds_u32*)(scr+GS_C); volatile lds_u32*Tj=(volatile lds_u32*)(scr+GS_TJ); volatile lds_u32*pre=(volatile lds_u32*)(scr+GS_PRE); volatile lds_u32*QP=(volatile lds_u32*)(scr+GS_QP); volatile lds_u32*RNG=(volatile lds_u32*)(scr+GS_RNG);
  MB_LAS float*wsf=(MB_LAS float*)(scr+GS_WSF)+wid*64; MB_LAS int*dstl=(MB_LAS int*)(scr+GS_DST)+wid*32; MB_LAS bf16*stg=(MB_LAS bf16*)(scr+GS_STG)+wid*(8*STG_LD);
  if(tid<32){ unsigned cj[32];
    #pragma unroll
    for(int q4=0;q4<8;++q4){ const u32x4 t4=*(const MB_GAS u32x4*)(cnt+(size_t)bh*1024+tid*32+4*q4); cj[4*q4]=t4[0]; cj[4*q4+1]=t4[1]; cj[4*q4+2]=t4[2]; cj[4*q4+3]=t4[3]; }
    unsigned run=0u;
    #pragma unroll
    for(int q=0;q<32;++q){ QP[tid*33+q]=run; run+=(q>tid)?cj[q]:0u; }
    QP[tid*33+32]=run; Tj[tid]=run;
    const unsigned n=(run+255u)>>8, wgt=n?2u*n+1u:0u; unsigned pn=n, pw=wgt;
    #pragma unroll
    for(int o=1;o<32;o<<=1){ const unsigned a=__shfl_up(pn,o,32), bq=__shfl_up(pw,o,32); if(tid>=o){ pn+=a; pw+=bq; } }
    const unsigned ntot=__shfl(pn,31,32), wt=__shfl(pw,31,32);
    pre[tid]=pn-n; if(tid==31)pre[32]=ntot;
    const unsigned p2=pw-wgt;
    #pragma unroll
    for(int k=0;k<2;++k){ const unsigned target=wt*(unsigned)(sv+k)/8u; unsigned cc=0u; if(n&&target>p2+1u){ cc=(target-p2)>>1; if(cc>n)cc=n; }
      #pragma unroll
      for(int o=16;o>=1;o>>=1) cc+=__shfl_xor(cc,o,32);
      if(tid==0)RNG[k]=cc; } }
  asm volatile("s_waitcnt vmcnt(0) lgkmcnt(0)\n\ts_barrier":::"memory");
  const int i0=(int)RNG[0], i1=(int)RNG[1];
  const unsigned hm=hi?0u:0xffffffffu;
  const float slope=__builtin_amdgcn_exp2f(-(float)(5+h)),sl2=slope*LOG2E;
  const float Lh=bfround(LOG2E),Ll=bfround(LOG2E-Lh);
  const unsigned w_A=cvtpk_s(slope*Lh,slope*Ll)&hm, w_32A=cvtpk_s(32.f*slope*Lh,32.f*slope*Ll)&hm;
  u32x4 ka,qa0,qa1;
  { const unsigned jw=cvtpk_s((float)r32,(float)r32)&hm; ka[0]=jw; ka[1]=0u; ka[2]=0x3f803f80u&hm; ka[3]=0x3f803f80u&hm;
    qa0[0]=w_A;qa0[1]=w_A;qa0[2]=0u;qa0[3]=0u; qa1[0]=w_A;qa1[1]=w_A;qa1[2]=0u;qa1[3]=w_32A; }
  const lds_cptr shm3=(lds_cptr)shm; const lds_cptr vp0=shm3+4*SLOTB+((lane>>4)&1)*32+(lane&3)*8+(4*hi+((lane&15)>>2))*64; const lds_cptr kp0=shm3+hi*1024+r32*16;
  const unsigned kdst=lds0+wid*1024, vdst=lds0+4*SLOTB+wid*1024;
  #define BLK_DMA(J,BUF) do{ const bf16*ks_=P+OFF_KA+((size_t)bh*SEQ+256L*(J)+lane)*64+wid*8; const bf16*vs_=P+OFF_VA+((size_t)bh*SEQ+256L*(J)+16*(wid&3)+(lane>>2))*64+(wid>>2)*32+(lane&3)*8; \
      _Pragma("unroll") for(int t=0;t<4;++t){ glds16(ks_+(long)t*KVBLK*64,(unsigned)__builtin_amdgcn_readfirstlane(kdst+(BUF)*65536+t*SLOTB)); glds16(vs_+(long)t*KVBLK*64,(unsigned)__builtin_amdgcn_readfirstlane(vdst+(BUF)*65536+t*SLOTB)); } }while(0)
  int jn=0;
  #define LOOKUP(IT,JO,EO,VO) do{ const int it_=(IT); JO=-1; EO=0u; VO=false; if(it_<i1){ while((int)pre[jn+1]<=it_)++jn; JO=jn; const int c_=it_-(int)pre[jn]; const int T_=(int)Tj[jn]; \
      const int g_=256*c_+wid*QBLK+r32; VO=g_<T_; const int gg_=VO?g_:T_-1; int qb_=0; _Pragma("unroll") for(int st=16;st>=1;st>>=1) if((int)QP[jn*33+qb_+st]<=gg_) qb_+=st; \
      const int idx_=gg_-(int)QP[jn*33+qb_]; EO=(unsigned)qb_<<16|(unsigned)*(const MB_GAS unsigned short*)(lst+(((size_t)bh*32+jn)*32+qb_)*256+idx_); } }while(0)
  #define QLOAD(EI,QO,TQO) do{ TQO=256*(int)((EI)>>16)+(int)((EI)&255u); const bf16*Qp_=P+OFF_QA+((size_t)bh*SEQ+TQO)*64+hi*8; _Pragma("unroll") for(int d0=0;d0<4;++d0)QO[d0]=*(const MB_GAS bf16x8*)(Qp_+d0*16); }while(0)
  int j0_,j1_,j2_; unsigned e0_,e1_,e2_; bool v0_,v1_,v2_; bf16x8 qr[4],qn[4]; int tq=0,tqn=0;
  LOOKUP(i0,j0_,e0_,v0_); LOOKUP(i0+1,j1_,e1_,v1_);
  if(i0<i1){ QLOAD(e0_,qr,tq); BLK_DMA(j0_,0); }
  int curj=-1,buf=1,pfj=(i0<i1)?j0_:-1;
  #pragma unroll 1
  for(int it=i0;it<i1;++it){
    const int j=j0_; const bool valid=v0_; const int slot=(int)((e0_>>8)&255u);
    if(j!=curj){ buf^=1; WAIT_BAR(0); curj=j; }
    LOOKUP(it+2,j2_,e2_,v2_);
    if(it+1<i1) QLOAD(e1_,qn,tqn);
    if(j1_>=0&&j1_!=j&&pfj!=j1_){
      asm volatile("s_waitcnt lgkmcnt(0)\n\ts_barrier":::"memory");
      BLK_DMA(j1_,buf^1); pfj=j1_; }
    const lds_cptr kpb=kp0+buf*65536, vpb=vp0+buf*65536;
    f32x16 o[2]; o[0]=f32x16{}; o[1]=f32x16{}; float l=0.f;
    chunk_attn<4,0>(o,l,qr,ka,qa0,qa1,hm,-255.f,kpb,vpb,0,r32,hi,0);
    { auto rr=__builtin_amdgcn_permlane32_swap(__float_as_uint(l),__float_as_uint(l),false,false); l=__uint_as_float(rr[0])+__uint_as_float(rr[1]); }
    const size_t prow=((size_t)bh*SEQ+tq)*4+slot;
    if(hi==0){ dstl[r32]=valid?(int)(prow*64):-1; if(valid) *(MB_GAS float*)(partL+prow)=l*__builtin_amdgcn_exp2f(sl2*(float)(256*j+255-tq)); }
    sp_store8(o,__builtin_amdgcn_rcpf(l),partO,dstl,wsf,stg,lane,r32,hi);
    j0_=j1_;e0_=e1_;v0_=v1_; j1_=j2_;e1_=e2_;v1_=v2_; tq=tqn;
    #pragma unroll
    for(int d0=0;d0<4;++d0)qr[d0]=qn[d0];
  }
  #undef LOOKUP
  #undef QLOAD
  #undef BLK_DMA
  asm volatile("s_waitcnt vmcnt(0) lgkmcnt(0)\n\ts_barrier":::"memory");
}
#undef SBAR
#undef WAIT_BAR
#undef MFMA32
#undef MX3
}
constexpr int NWAVES = 8;
#ifndef IN_ONE_CALL
#define IN_ONE_CALL 0
#endif
#ifndef STAGGER_IN
#define STAGGER_IN 0
#endif
#ifndef STAGGER_OUT
#define STAGGER_OUT 0
#endif
#ifndef MK_N_LAUNCHES
#define MK_N_LAUNCHES 1
#endif
constexpr int N_LAUNCHES = MK_N_LAUNCHES;
constexpr int N_PHASES = 11;
static_assert(WS_WIN + 2 * (size_t)NPROJ * DM * 2 <= WS_WOUT && WS_WOUT + 2 * (size_t)DM * DM * 2 <= WS_XB && WS_XB + (size_t)M * DM * 2 <= WS_Y && WS_Y + (size_t)M * DM * 2 <= WS_PROJ && WS_PROJ + (size_t)M * NPROJ * 2 <= WS_END, "d_ws map");
constexpr int CW_TMO = 0, CW_BAR = 4096;
static_assert((CW_BAR + XCD_BAR_WORDS) * 4 <= (int)WS_KMEAN && WS_KMEAN + 2 * 65536 * 4 <= WS_SSQ2 && WS_SSQ2 + (size_t)M * 4 <= CTL_ZERO_BYTES, "ctl map");
constexpr int RING_OFF = 0, RING_BYTES = 131072;
constexpr int LDSCTL_OFF = RING_BYTES, MISC_OFF = LDSCTL_OFF + 320, AUX_OFF = RING_BYTES + 4096;
constexpr int SCR_OFF = AUX_OFF + 4096;
constexpr int LDS_BYTES = 163840;
static_assert(SCR_OFF + moba_body::GS_BYTES <= LDS_BYTES, "LDS map");

struct Frame {
    LAS unsigned char* lds; volatile LAS unsigned* MISC; gu32* ctl;
    int tid, lane, wave, vcu, G;
    const float *x, *norm_g, *w_in, *w_out, *a_qn, *a_kn, *pool_w, *pool_scale, *c_qn, *c_kn, *c_sinks, *conv_w;
    float* out;
    bf16 *Win_t, *Wout_t, *XB, *Y, *PROJ; float *kmean, *ssq1, *ssq2;
    unsigned* cnt; unsigned short* lst; bf16* partO; float* partL; float *Hu, *Hg;
    __device__ __forceinline__ void refresh() { int t = threadIdx.x; asm volatile("" : "+v"(t)); tid = t; lane = t & 63; wave = __builtin_amdgcn_readfirstlane(t >> 6); int v = vcu; asm volatile("" : "+s"(v)); vcu = v; }
};
__device__ __forceinline__ float bf2f(bf16 b) { return __uint_as_float((unsigned)b << 16); }
__device__ __forceinline__ float wave_sum(float v) {
#pragma unroll
    for (int o = 1; o < 64; o <<= 1) v += __shfl_xor(v, o);
    return v;
}
__device__ __forceinline__ float wave_max(float v) {
#pragma unroll
    for (int o = 1; o < 64; o <<= 1) v = fmaxf(v, __shfl_xor(v, o));
    return v;
}
__device__ __forceinline__ float rdl(float v, int l) { return __uint_as_float((unsigned)__builtin_amdgcn_readlane((int)__float_as_uint(v), l)); }
__device__ __forceinline__ void p0_store_item(LAS float* scr, bf16* WT, int n0, bool mapped, int k0, int lane) {
    LDS_WAIT(); asm volatile("" ::: "memory");
    const int c = lane & 7;
#pragma unroll
    for (int j = 0; j < 4; ++j) { const int n = (lane >> 3) + 8 * j; const LAS float* s = scr + (8 * c) * 33 + n;
        v4u o; o.x = pk2(s[0 * 33], s[1 * 33]); o.y = pk2(s[2 * 33], s[3 * 33]); o.z = pk2(s[4 * 33], s[5 * 33]); o.w = pk2(s[6 * 33], s[7 * 33]);
        const int prow = mapped ? phys_row(n0 + n) : n0 + n;
        *(GAS v4u*)(WT + (size_t)prow * 1024 + k0 + 8 * c) = o; }
    LDS_WAIT(); asm volatile("" ::: "memory");
}
__device__ __forceinline__ void p0_prologue(Frame& F) {
    F.refresh();
    LAS float* scr = (LAS float*)(F.lds + RING_OFF + F.wave * 16384);
    const int gw = F.vcu * NWAVES + F.wave, NGW = F.G * NWAVES, lane = F.lane;
    constexpr int I_IN = 16 * 104, I_OUT = 16 * 32, I_L = I_IN + I_OUT;
    for (int it = gw; it < NLAYER * I_L; it += NGW) {
        const int l = it / I_L; int r = it % I_L;
        if (r < I_IN) {
            const int kb = r / 104, nb = r % 104, k0 = 64 * kb, n0 = 32 * nb;
            const float* W = F.w_in + (size_t)l * 1024 * NPROJ; const float* gn = F.norm_g + l * 1024;
            if (n0 >= C_BU && n0 < C_BG) {
                const int g = (n0 - C_BU) >> 6, np0 = (n0 - C_BU) & 63; const float* pw = F.pool_w + ((size_t)l * 4 + g) * 64 * 64 + np0; const float* ps = F.pool_scale + l * 256 + (n0 - C_BU);
                const GAS f32x4* wrow = (const GAS f32x4*)(W + (size_t)(k0 + lane) * NPROJ + C_BU + 64 * g); float wv[64], accp[32];
#pragma unroll
                for (int q = 0; q < 16; ++q) { const f32x4 t4 = wrow[q]; wv[4 * q] = t4.x; wv[4 * q + 1] = t4.y; wv[4 * q + 2] = t4.z; wv[4 * q + 3] = t4.w; }
#pragma unroll
                for (int n = 0; n < 32; ++n) accp[n] = 0.f;
#pragma unroll
                for (int cc = 0; cc < 64; ++cc) {
#pragma unroll
                    for (int n = 0; n < 32; ++n) accp[n] += wv[cc] * pw[cc * 64 + n]; }
                const float gk = gn[k0 + lane];
#pragma unroll
                for (int n = 0; n < 32; ++n) scr[lane * 33 + n] = accp[n] * ps[n] * gk;
            } else {
#pragma unroll 8
                for (int i = 0; i < 32; ++i) { const int kk = 2 * i + (lane >> 5); scr[kk * 33 + (lane & 31)] = W[(size_t)(k0 + kk) * NPROJ + n0 + (lane & 31)] * gn[k0 + kk]; }
            }
            p0_store_item(scr, F.Win_t + (size_t)l * NPROJ * 1024, n0, true, k0, lane);
        } else {
            r -= I_IN; const int kb = r / 32, nb = r % 32, k0 = 64 * kb, n0 = 32 * nb; const float* W = F.w_out + (size_t)l * 1024 * 1024;
#pragma unroll 8
            for (int i = 0; i < 32; ++i) { const int kk = 2 * i + (lane >> 5); scr[kk * 33 + (lane & 31)] = W[(size_t)(k0 + kk) * 1024 + n0 + (lane & 31)]; }
            p0_store_item(scr, F.Wout_t + (size_t)l * 1024 * 1024, n0, false, k0, lane);
        }
    }
    { GAS f32x4* z0 = (GAS f32x4*)F.kmean; GAS f32x4* z1 = (GAS f32x4*)F.ssq2; const int gtid = F.vcu * (NWAVES * 64) + F.tid, ngt = F.G * NWAVES * 64;
      for (int i = gtid; i < 2 * 65536 / 4; i += ngt) z0[i] = (f32x4){0.f, 0.f, 0.f, 0.f};
      for (int i = gtid; i < M / 4; i += ngt) z1[i] = (f32x4){0.f, 0.f, 0.f, 0.f}; }
    for (int m0 = 4 * gw; m0 < M; m0 += 4 * NGW) {
        f32x4 v[4][4]; float s[4];
#pragma unroll
        for (int q = 0; q < 4; ++q) { const GAS f32x4* xr = (const GAS f32x4*)(F.x + (size_t)(m0 + q) * DM) + lane;
#pragma unroll
            for (int j = 0; j < 4; ++j) v[q][j] = __builtin_nontemporal_load(xr + 64 * j); }
#pragma unroll
        for (int q = 0; q < 4; ++q) { s[q] = 0.f;
#pragma unroll
            for (int j = 0; j < 4; ++j) s[q] += (v[q][j].x * v[q][j].x + v[q][j].y * v[q][j].y) + (v[q][j].z * v[q][j].z + v[q][j].w * v[q][j].w); }
#pragma unroll
        for (int o = 1; o < 64; o <<= 1) {
#pragma unroll
            for (int q = 0; q < 4; ++q) s[q] += __shfl_xor(s[q], o); }
        if (lane < 4) F.ssq1[m0 + lane] = lane == 0 ? s[0] : lane == 1 ? s[1] : lane == 2 ? s[2] : s[3];
#pragma unroll
        for (int q = 0; q < 4; ++q) { GAS unsigned long long* o8 = (GAS unsigned long long*)(F.XB + (size_t)(m0 + q) * DM) + lane;
#pragma unroll
            for (int j = 0; j < 4; ++j) o8[64 * j] = (unsigned long long)pk2(v[q][j].x, v[q][j].y) | ((unsigned long long)pk2(v[q][j].z, v[q][j].w) << 32); }
    }
}
__device__ __forceinline__ void convfix_phase(Frame& F, int layer) {
    F.refresh();
    const int gt = F.vcu * (NWAVES * 64) + F.tid, NGT = F.G * NWAVES * 64; const float* cw = F.conv_w + (size_t)layer * 768;
    for (int it = gt; it < 256 * 2 * 256; it += NGT) { const int c = it & 255, r = (it >> 8) & 1, pm = it >> 9;
        if ((pm & 31) == 0) continue;
        const float u1 = F.Hu[((size_t)(pm - 1) * 2 + 1) * 256 + c], u2 = F.Hu[((size_t)(pm - 1) * 2 + 0) * 256 + c], g = F.Hg[((size_t)pm * 2 + r) * 256 + c];
        const float fix = g * (r == 0 ? cw[c] * u2 + cw[256 + c] * u1 : cw[c] * u1);
        bf16* y = F.Y + (size_t)(pm * 256 + r) * DM + 768 + c; *y = (bf16)f2bf(bf2f(*y) + fix); }
}
__device__ __forceinline__ void poolfix_phase(Frame& F, int layer) {
    F.refresh();
    const float* Hpu = (const float*)((const char*)F.PROJ - WS_PROJ + WS_PHALO); const float* Hpg = Hpu + 256 * 16 * 256;
    const int gt = F.vcu * (NWAVES * 64) + F.tid, NGT = F.G * NWAVES * 64;
    for (int it = gt; it < 256 * 256; it += NGT) { const int c = it & 255, pm = it >> 8;
        if ((pm & 31) == 0) continue;
        const int w = 2 << (c >> 6); float up[15], gq[15], yv[15];
#pragma unroll
        for (int d = 1; d <= 15; ++d) up[d - 1] = d < w ? Hpu[((size_t)(pm - 1) * 16 + 16 - d) * 256 + c] : 0.f;
#pragma unroll
        for (int r = 0; r < 15; ++r) { const bool on = r < w - 1; gq[r] = on ? Hpg[((size_t)pm * 16 + r) * 256 + c] : 0.f; yv[r] = on ? bf2f(F.Y[(size_t)(pm * 256 + r) * DM + 256 + c]) : 0.f; }
        float s = 0.f;
#pragma unroll
        for (int d = 0; d < 15; ++d) s += up[d];
        const float iw = 1.0f / (float)w;
#pragma unroll
        for (int r = 0; r < 15; ++r) { if (r < w - 1) { F.Y[(size_t)(pm * 256 + r) * DM + 256 + c] = (bf16)f2bf(yv[r] + s * iw * gq[r]); s -= up[w - 2 - r]; } }
    }
}
struct Args { const float* in[12]; float* out; unsigned char* ws; int ph_lo, ph_hi, li, pad; };
__global__ void __launch_bounds__(NWAVES * 64, 2) hybrid_fwd(Args args) {
    extern __shared__ __attribute__((aligned(16))) unsigned char lds[];
    Frame F;
    F.lds = (LAS unsigned char*)lds; F.MISC = (volatile LAS unsigned*)(F.lds + MISC_OFF);
    F.tid = threadIdx.x; F.lane = F.tid & 63; F.wave = __builtin_amdgcn_readfirstlane(F.tid >> 6);
    F.G = gridDim.x; { const int bx = blockIdx.x; F.vcu = (F.G % 8 == 0) ? (bx % 8) * (F.G / 8) + bx / 8 : bx; }
    unsigned char* ws = args.ws;
    F.ctl = (gu32*)(ws + WS_CTL);
    F.x = args.in[0]; F.norm_g = args.in[1]; F.w_in = args.in[2]; F.w_out = args.in[3]; F.a_qn = args.in[4]; F.a_kn = args.in[5]; F.pool_w = args.in[6]; F.pool_scale = args.in[7];
    F.c_qn = args.in[8]; F.c_kn = args.in[9]; F.c_sinks = args.in[10]; F.conv_w = args.in[11]; F.out = args.out;
    F.Win_t = (bf16*)(ws + WS_WIN); F.Wout_t = (bf16*)(ws + WS_WOUT); F.XB = (bf16*)(ws + WS_XB); F.Y = (bf16*)(ws + WS_Y); F.PROJ = (bf16*)(ws + WS_PROJ);
    F.kmean = (float*)(ws + WS_KMEAN); F.ssq1 = (float*)(ws + WS_SSQ1); F.ssq2 = (float*)(ws + WS_SSQ2);
    F.cnt = (unsigned*)(ws + WS_CNT); F.lst = (unsigned short*)(ws + WS_LST); F.partO = (bf16*)(ws + WS_PARTO); F.partL = (float*)(ws + WS_PARTL); F.Hu = (float*)(ws + WS_HALO); F.Hg = F.Hu + 256 * 2 * 256;
    for (int u = F.tid; u < (AUX_OFF - LDSCTL_OFF) / 4; u += NWAVES * 64) ((LAS unsigned*)(F.lds + LDSCTL_OFF))[u] = 0u;
    __syncthreads();
    XcdBarrier bar; bar.bar = (unsigned*)(F.ctl + CW_BAR); bar.x = 0; bar.st = nullptr;
    if (N_LAUNCHES == 1) bar = xcd_barrier_post((unsigned*)(F.ctl + CW_BAR), F.MISC + 8);
    const int lo = args.ph_lo, hi = args.ph_hi;
#define IN(k) (lo <= (k) && (k) < hi)
#define SEAM(k) do { if (IN(k) && IN((k) + 1)) { xcd_barrier(bar); if (PROBE_DUP == 7) xcd_barrier(bar); } } while (0)
    if (IN(0)) { p0_prologue(F); if (PROBE_DUP == 1) p0_prologue(F); } SEAM(0);
    for (int l = 0; l < NLAYER; ++l) {
        const int p0 = 1 + 5 * l;
        if (IN(p0)) {
            pg8::Gemm g{F.XB, F.Win_t + (size_t)l * NPROJ * 1024, M, 1792, DM}; pg8::StaticOrder S; S.init(M, 1792, F.G, (int)blockIdx.x);
            pg8::EpiInProj E{F.PROJ, l, 1};
            { F.refresh(); LAS float* gl = (LAS float*)(F.lds + AUX_OFF + 2048);
              if (F.tid < 256) { const float* src = (F.tid < 64 ? F.a_qn : F.tid < 128 ? F.a_kn : F.tid < 192 ? F.c_qn : F.c_kn) + l * 64 + (F.tid & 63); gl[F.tid] = *src; }
              { LAS float* cwl = (LAS float*)(F.lds + AUX_OFF + 4096); for (int i = F.tid; i < 768; i += NWAVES * 64) cwl[i] = F.conv_w[(size_t)l * 768 + i]; }
              __syncthreads(); }
            if (PROBE_DUP == 8) { pg8::EpiPlain E2{F.PROJ, NPROJ}; pg8::gemm_phase<pg8::EpiPlain, pg8::StaticOrder, true, true>(F.lds + RING_OFF, F.lds + AUX_OFF, g, S, E2); }
            if (PROBE_DUP == 9) { pg8::EpiNull E2{}; pg8::gemm_phase<pg8::EpiNull, pg8::StaticOrder, true, true>(F.lds + RING_OFF, F.lds + AUX_OFF, g, S, E2); }
            if (STAGGER_IN > 0) { const unsigned long long t0 = rt(); const unsigned long long dl = (unsigned long long)((F.vcu & 3) * STAGGER_IN); while (rt() - t0 < dl) __builtin_amdgcn_s_sleep(8); }
#if IN_ONE_CALL
            { pg8::Gemm ga{F.XB, F.Win_t + (size_t)l * NPROJ * 1024, M, NPROJ, DM}; pg8::StaticOrder Sa; Sa.init(M, NPROJ, F.G, (int)blockIdx.x); pg8::EpiInAll Ea{F.PROJ, l, 1};
              pg8::gemm_phase<pg8::EpiInAll, pg8::StaticOrder, true, true>(F.lds + RING_OFF, F.lds + AUX_OFF, ga, Sa, Ea); }
#else
            pg8::gemm_phase<pg8::EpiInProj, pg8::StaticOrder, true, true>(F.lds + RING_OFF, F.lds + AUX_OFF, g, S, E);
            { pg8::Gemm gp{F.XB, F.Win_t + (size_t)l * NPROJ * 1024 + (size_t)1792 * 1024, M, 1536, DM}; pg8::StaticOrder Sp; Sp.init(M, 1536, F.G, (int)blockIdx.x); pg8::EpiPoolConv Ep{F.PROJ, l};
              for (int rep = 0; rep < (PROBE_DUP == 14 ? 2 : 1); ++rep) pg8::gemm_phase<pg8::EpiPoolConv, pg8::StaticOrder, true, true>(F.lds + RING_OFF, F.lds + AUX_OFF, gp, Sp, Ep); }
#endif
            if (PROBE_DUP == 2) { pg8::EpiInProj E2 = E; E2.do_km = 0; pg8::gemm_phase<pg8::EpiInProj, pg8::StaticOrder, true, true>(F.lds + RING_OFF, F.lds + AUX_OFF, g, S, E2); }
        }
        SEAM(p0);
        if (IN(p0 + 1)) { F.refresh();
            moba_body::select_phase((char*)lds + SCR_OFF, F.PROJ, F.kmean + (size_t)l * 65536, F.cnt + (size_t)l * 32768, F.lst, F.vcu, F.G);
            for (int rep = 0; rep < (PROBE_DUP == 4 ? 2 : 1); ++rep) moba_body::swa_phase((char*)lds + RING_OFF, (char*)lds + SCR_OFF, F.PROJ, F.c_sinks + l * 4, F.Y, F.vcu, F.G); }
        SEAM(p0 + 1);
        if (IN(p0 + 2)) { F.refresh();
            for (int rep = 0; rep < (PROBE_DUP == 11 ? 2 : 1); ++rep) moba_body::gather_phase((char*)lds + RING_OFF, (char*)lds + SCR_OFF, F.PROJ, F.cnt + (size_t)l * 32768, F.lst, F.partO, F.partL, F.vcu);
        }
        SEAM(p0 + 2);
        if (IN(p0 + 3)) {
            for (int rep = 0; rep < (PROBE_DUP == 12 ? 2 : 1); ++rep) moba_body::own_merge_phase((char*)lds + RING_OFF, (char*)lds + SCR_OFF, F.PROJ, F.partO, F.partL, F.Y, F.vcu, F.G);
            convfix_phase(F, l); poolfix_phase(F, l); }
        SEAM(p0 + 3);
        if (IN(p0 + 4)) {
            pg8::Gemm g{F.Y, F.Wout_t + (size_t)l * 1024 * 1024, M, DM, DM}; pg8::StaticOrder S; S.init(M, DM, F.G, (int)blockIdx.x);
            pg8::EpiOutProj E{F.XB, l == 0 ? nullptr : F.out, l == 0 ? F.XB : nullptr, F.ssq2};
            if (PROBE_DUP == 10) { pg8::EpiNull E2{}; pg8::gemm_phase<pg8::EpiNull, pg8::StaticOrder, true, true>(F.lds + RING_OFF, F.lds + AUX_OFF, g, S, E2); }
            if (PROBE_DUP == 6) { pg8::EpiOutProj E2{F.XB, (float*)F.partO, nullptr, F.ssq2}; pg8::gemm_phase<pg8::EpiOutProj, pg8::StaticOrder, true, true>(F.lds + RING_OFF, F.lds + AUX_OFF, g, S, E2); }
            if (STAGGER_OUT > 0) { const unsigned long long t0 = rt(); const unsigned long long dl = (unsigned long long)((F.vcu & 3) * STAGGER_OUT); while (rt() - t0 < dl) __builtin_amdgcn_s_sleep(8); }
            pg8::gemm_phase<pg8::EpiOutProj, pg8::StaticOrder, true, true>(F.lds + RING_OFF, F.lds + AUX_OFF, g, S, E);
        }
        if (l + 1 < NLAYER) SEAM(p0 + 4);
    }
#undef IN
#undef SEAM
}
extern "C" void kernel_launch(void* const* d_in, const int* in_sizes, int n_in, void* d_out, int out_size, void* d_ws, size_t ws_size, hipStream_t stream) {
    static int grid = 0;
    if (grid == 0) {
        if (n_in != 12 || in_sizes[0] != M * DM || out_size != M * DM || ws_size < WS_END) { fprintf(stderr, "kernel_launch: unexpected shapes (n_in %d, in0 %d, out %d, ws %zu); nothing launched\n", n_in, n_in > 0 ? in_sizes[0] : -1, out_size, ws_size); grid = -1; return; }
        int dev = 0, cus = 0;
        if (hipGetDevice(&dev) != hipSuccess || hipDeviceGetAttribute(&cus, hipDeviceAttributeMultiprocessorCount, dev) != hipSuccess) { grid = -1; return; }
        if (hipFuncSetAttribute((const void*)hybrid_fwd, hipFuncAttributeMaxDynamicSharedMemorySize, LDS_BYTES) != hipSuccess) { fprintf(stderr, "kernel_launch: hipFuncSetAttribute failed\n"); grid = -1; return; }
        (void)hipGetLastError();
        grid = cus;
    }
    if (grid < 0) return;
    if (hipMemsetAsync((char*)d_ws + WS_CTL, 0, 64 * 1024, stream) != hipSuccess) return;
    Args a{};
    for (int i = 0; i < 12; ++i) a.in[i] = (const float*)d_in[i];
    a.out = (float*)d_out; a.ws = (unsigned char*)d_ws;
    for (int li = 0; li < N_LAUNCHES; ++li) {
        a.ph_lo = (N_LAUNCHES == 1) ? 0 : li; a.ph_hi = (N_LAUNCHES == 1) ? N_PHASES : li + 1; a.li = li;
        hipLaunchKernelGGL(hybrid_fwd, dim3(grid), dim3(NWAVES * 64), LDS_BYTES, stream, a);
    }
}
```

```cpp
#include <hip/hip_runtime.h>
#include <cstdio>
#include <cstdint>
#include <cmath>
constexpr int NB = 8, SEQ = 8192, DM = 1024, NPROJ = 3328, M = NB * SEQ, NLAYER = 2;
constexpr int C_AQ = 0, C_AK = 256, C_AV = 512, C_AG = 768, C_BU = 1024, C_BG = 1280, C_CQ = 1536, C_CK = 1792, C_CV = 1920, C_CG = 2048, C_DH = 2304, C_DB = 2560, C_DC = 2816, C_DG = 3072;
#ifndef PROBE_DUP
#define PROBE_DUP 0
#endif

constexpr size_t OFF_QA = 0, OFF_KA = 16ull << 20, OFF_VA = 32ull << 20, OFF_GA = 48ull << 20, OFF_QC = 64ull << 20, OFF_KC = 80ull << 20, OFF_VC = 88ull << 20, OFF_GC = 96ull << 20;
__host__ __device__ __forceinline__ int phys_row(int c) {
    if (c >= C_DH) { const int op = (c - C_DH) >> 8, ch = (c - C_DH) & 255, j = ch >> 6, wc = (ch >> 4) & 3, fq = (ch >> 2) & 3, e = ch & 3; return (9 + j) * 256 + 128 * (op >> 1) + 32 * wc + 8 * fq + 4 * (op & 1) + e; }
    if (c >= C_BU && c < C_CQ) { const int gate = c >= C_BG, ch = c - (gate ? C_BG : C_BU); return (7 + (ch >> 7)) * 256 + 128 * gate + (ch & 127); }
    const int lt = c >> 8, t = lt < 4 ? lt : lt - 2, cc = c & 255; return t * 256 + 128 * ((cc >> 5) & 1) + 32 * (cc >> 6) + (cc & 31);
}

constexpr size_t MiB = 1u << 20;
constexpr size_t WS_CTL = 0, CTL_ZERO_BYTES = 2 * MiB;
constexpr size_t WS_KMEAN = 256 * 1024;
constexpr size_t WS_SSQ2 = 1 * MiB;
constexpr size_t WS_SSQ1 = 2 * MiB;
constexpr size_t WS_WIN = 4 * MiB;
constexpr size_t WS_WOUT = 18 * MiB;
constexpr size_t WS_XB = 32 * MiB;
constexpr size_t WS_Y = 160 * MiB;
constexpr size_t WS_PROJ = 288 * MiB;
constexpr size_t WS_LST = 704 * MiB;
constexpr size_t WS_CNT = 1280 * 1024;
constexpr size_t WS_PARTL = 721 * MiB;
constexpr size_t WS_HALO = 726 * MiB;
constexpr size_t WS_PHALO = 727 * MiB;
constexpr size_t WS_PARTO = 736 * MiB;
constexpr size_t WS_END = 864 * MiB;
namespace pg8 {
#define PG8_LAS __attribute__((address_space(3)))
typedef unsigned short bf16_t;
typedef short bf16x8 __attribute__((ext_vector_type(8)));
typedef float f32x4 __attribute__((ext_vector_type(4)));
typedef unsigned u32x4 __attribute__((ext_vector_type(4)));
constexpr int BM = 256, BK = 64, HALF = 128, HTB = HALF * BK * 2  , STAGE_BYTES = 8 * HTB, NXCD = 8, WGM = 8;

__host__ __device__ __forceinline__ int lds_byte(int r, int c) { const int st = (r >> 4) * 2 + (c >> 5), rr = r & 15, cc = c & 31, ob = rr * 64 + cc * 2; return st * 1024 + (ob ^ (((ob >> 9) & 1) << 5)); }
__host__ __device__ __forceinline__ void stage_rc(int b, int& R, int& C) { const int st = b / 1024, sb = b % 1024, swz = sb ^ (((sb >> 9) & 1) << 5); R = (st >> 1) * 16 + swz / 64; C = (st & 1) * 32 + (swz % 64) / 2; }
__host__ __device__ __forceinline__ int perm32(int rho) { const int n = rho >> 4, i = rho & 15; return 8 * (i >> 2) + 4 * n + (i & 3); }

struct Unit { int pm, pn; };
struct Gemm { const bf16_t* A; const bf16_t* Bt; int M, N, K; };

struct StaticOrder {
    int nM, nN, nwg, G, c;
    __host__ __device__ void init(int M, int N, int G_, int c_) { nM = M / BM; nN = N / BM; nwg = nM * nN; G = G_; c = c_; }
    __host__ __device__ bool next(int i, Unit& u) const {
        const long L = (long)i * G + c; if (L >= nwg) return false;
        int wgid = (int)L; { const int q = nwg / NXCD, r = nwg % NXCD, xcd = wgid % NXCD, off = wgid / NXCD; wgid = (xcd < r ? xcd * (q + 1) : r * (q + 1) + (xcd - r) * q) + off; }
        const int nig = WGM * nN, gid = wgid / nig, fm = gid * WGM, gsz = (nM - fm) < WGM ? (nM - fm) : WGM;
        u.pm = fm + ((wgid % nig) % gsz); u.pn = (wgid % nig) / gsz; return true;
    }
    __device__ __forceinline__ void a_ready(const Unit&) const {}
    __device__ __forceinline__ void done(const Unit&) const {}
};

typedef float pg8_f32x2 __attribute__((ext_vector_type(2))); typedef __bf16 pg8_bf16x2 __attribute__((ext_vector_type(2)));
__device__ __forceinline__ unsigned cvt_pk_bf16(float lo, float hi) { pg8_f32x2 v = {lo, hi}; pg8_bf16x2 b = __builtin_convertvector(v, pg8_bf16x2); return __builtin_bit_cast(unsigned, b); }
typedef float f32x2 __attribute__((ext_vector_type(2)));
#define PG8_GAS __attribute__((address_space(1)))
constexpr float QK_C2 = 0.125f * 1.4426950408889634f;
struct EpiInProj {
    static constexpr bool PERM = true, AFTER_DRAIN = false;
    bf16_t* P; int layer; int do_km;
    __device__ __forceinline__ char* wsb() const { return (char*)P - WS_PROJ; }
    __device__ __forceinline__ void prefetch(PG8_LAS unsigned char* aux, const Unit& u, int ui, int wid, int lane) const {
        const float* ssq = (const float*)(wsb() + (layer == 0 ? WS_SSQ1 : WS_SSQ2));
        if (wid == 0) __builtin_amdgcn_global_load_lds((const unsigned*)(ssq + (size_t)u.pm * BM + lane * 4), (PG8_LAS unsigned*)(aux + (ui & 1) * 1024), 16, 0, 0);
    }
    __device__ __forceinline__ void operator()(const f32x4 (&acc)[2][2][4][2], const Unit& u, int wr, int wc, int fr_in, int fq_in, PG8_LAS unsigned char* aux, int ui) const {
        int fr = fr_in, fq = fq_in; asm volatile("" : "+v"(fr), "+v"(fq));
        const int pn = u.pn;
        const PG8_LAS float* rv = (const PG8_LAS float*)(aux + (ui & 1) * 1024); const PG8_LAS float* gl = (const PG8_LAS float*)(aux + 2048);
        int g = -1; float post = 1.f; bool silu = false, km = false;
        const int lt = pn < 4 ? pn : pn + 2;
        if (lt == 0) { g = 0; post = QK_C2; } else if (lt == 1) { g = 64; km = (do_km != 0); } else if (lt == 6) { g = 128; post = QK_C2; }
        else if (lt == 7) { if (wc < 2) g = 192; } else if (lt == 3 || lt == 8) silu = true;
        float scl[2][4];
#pragma unroll
        for (int ai = 0; ai < 2; ++ai)
#pragma unroll
            for (int m = 0; m < 4; ++m) {
                float sr = __builtin_amdgcn_rsqf(rv[ai * HALF + wr * 64 + m * 16 + fr] * (1.0f / 1024.0f) + 1e-6f);
                if (g >= 0) { float ss = 0.f;
#pragma unroll
                    for (int bj = 0; bj < 2; ++bj)
#pragma unroll
                        for (int n = 0; n < 2; ++n) { const f32x4 q = acc[ai][bj][m][n] * acc[ai][bj][m][n]; ss += (q[0] + q[1]) + (q[2] + q[3]); }
                    ss += __shfl_xor(ss, 16); ss += __shfl_xor(ss, 32);
                    sr = sr * post * __builtin_amdgcn_rsqf(ss * sr * sr * (1.0f / 64.0f) + 1e-6f); }
                scl[ai][m] = sr; }
        const int bb = u.pm >> 5;
        size_t hbase;
        if (lt == 0) hbase = OFF_QA + (size_t)(bb * 4 + wc) * SEQ * 64; else if (lt == 1) hbase = OFF_KA + (size_t)(bb * 4 + wc) * SEQ * 64; else if (lt == 2) hbase = OFF_VA + (size_t)(bb * 4 + wc) * SEQ * 64;
        else if (lt == 3) hbase = OFF_GA + (size_t)(bb * 4 + wc) * SEQ * 64; else if (lt == 6) hbase = OFF_QC + (size_t)(bb * 4 + wc) * SEQ * 64;
        else if (lt == 7) hbase = (wc < 2 ? OFF_KC + (size_t)(bb * 2 + wc) * SEQ * 64 : OFF_VC + (size_t)(bb * 2 + wc - 2) * SEQ * 64); else hbase = OFF_GC + (size_t)(bb * 4 + wc) * SEQ * 64;
        const int lcol = 8 * fq + ((fr >> 3) << 5); const bool lo8 = fr < 8;
        f32x4 cs[2][2], gq[2][2];
#pragma unroll
        for (int bj = 0; bj < 2; ++bj) { cs[bj][0] = (f32x4){0.f, 0.f, 0.f, 0.f}; cs[bj][1] = cs[bj][0]; gq[bj][0] = (f32x4){1.f, 1.f, 1.f, 1.f}; gq[bj][1] = gq[bj][0];
            if (g >= 0) { gq[bj][0] = *(const PG8_LAS f32x4*)(gl + g + 32 * bj + 8 * fq); gq[bj][1] = *(const PG8_LAS f32x4*)(gl + g + 32 * bj + 8 * fq + 4); } }
#pragma unroll
        for (int ai = 0; ai < 2; ++ai)
#pragma unroll
            for (int m = 0; m < 4; ++m) {
                u32x4 w[2];
#pragma unroll
                for (int bj = 0; bj < 2; ++bj) {
                    f32x4 v0 = acc[ai][bj][m][0] * scl[ai][m] * gq[bj][0], v1 = acc[ai][bj][m][1] * scl[ai][m] * gq[bj][1];
                    if (silu) {
#pragma unroll
                        for (int e = 0; e < 4; ++e) { v0[e] = v0[e] * __builtin_amdgcn_rcpf(1.0f + __builtin_amdgcn_exp2f(-1.4426950408889634f * v0[e])); v1[e] = v1[e] * __builtin_amdgcn_rcpf(1.0f + __builtin_amdgcn_exp2f(-1.4426950408889634f * v1[e])); } }
                    if (km) { cs[bj][0] += v0; cs[bj][1] += v1; }
                    w[bj].x = cvt_pk_bf16(v0[0], v0[1]); w[bj].y = cvt_pk_bf16(v0[2], v0[3]); w[bj].z = cvt_pk_bf16(v1[0], v1[1]); w[bj].w = cvt_pk_bf16(v1[2], v1[3]); }
                u32x4 st1, st2;
#pragma unroll
                for (int e = 0; e < 4; ++e) { const unsigned give = lo8 ? w[1][e] : w[0][e]; const unsigned recv = (unsigned)__builtin_amdgcn_mov_dpp((int)give, 0x128, 0xf, 0xf, false);
                    st1[e] = lo8 ? w[0][e] : recv; st2[e] = lo8 ? recv : w[1][e]; }
                const size_t t0 = (size_t)((u.pm & 31) * BM + ai * HALF + wr * 64 + m * 16 + (fr & 7));
                __builtin_nontemporal_store(st1, (PG8_GAS u32x4*)(P + hbase + t0 * 64 + lcol)); __builtin_nontemporal_store(st2, (PG8_GAS u32x4*)(P + hbase + (t0 + 8) * 64 + lcol)); }
        if (km) {
#pragma unroll
            for (int bj = 0; bj < 2; ++bj) {
                float* kmp = (float*)(wsb() + WS_KMEAN) + (size_t)layer * 65536 + ((size_t)((u.pm >> 5) * 4 + wc) * 32 + (u.pm & 31)) * 64 + 32 * bj + 8 * fq;
#pragma unroll
                for (int e = 0; e < 8; ++e) { float s = e < 4 ? cs[bj][0][e & 3] : cs[bj][1][e & 3]; s += __shfl_xor(s, 1); s += __shfl_xor(s, 2); s += __shfl_xor(s, 4); s += __shfl_xor(s, 8);
                    if (fr == 0) __hip_atomic_fetch_add((PG8_GAS float*)(kmp + e), s * (1.0f / 256.0f), __ATOMIC_RELAXED, __HIP_MEMORY_SCOPE_AGENT); } } }
    }
};

struct EpiConv {
    static constexpr bool PERM = true, AFTER_DRAIN = false;
    bf16_t* P; int layer;
    __device__ __forceinline__ char* wsb() const { return (char*)P - WS_PROJ; }
    __device__ __forceinline__ void prefetch(PG8_LAS unsigned char* aux, const Unit& u, int ui, int wid, int lane) const {
        const float* ssq = (const float*)(wsb() + (layer == 0 ? WS_SSQ1 : WS_SSQ2));
        if (wid == 0) __builtin_amdgcn_global_load_lds((const unsigned*)(ssq + (size_t)u.pm * BM + lane * 4), (PG8_LAS unsigned*)(aux + (ui & 1) * 1024), 16, 0, 0);
    }
    __device__ __forceinline__ void operator()(const f32x4 (&acc)[2][2][4][2], const Unit& u, int wr, int wc, int fr_in, int fq_in, PG8_LAS unsigned char* aux, int ui) const {
        int fr = fr_in, fq = fq_in; asm volatile("" : "+v"(fr), "+v"(fq));
        const PG8_LAS float* rv = (const PG8_LAS float*)(aux + (ui & 1) * 1024);
        float scl[2][4];
#pragma unroll
        for (int ai = 0; ai < 2; ++ai)
#pragma unroll
            for (int m = 0; m < 4; ++m) scl[ai][m] = __builtin_amdgcn_rsqf(rv[ai * HALF + wr * 64 + m * 16 + fr] * (1.0f / 1024.0f) + 1e-6f);
        {
            const int j = u.pn, chg = 64 * j + 16 * wc + 4 * fq;
            bf16_t* Y = (bf16_t*)(wsb() + WS_Y); float* Hu = (float*)(wsb() + WS_HALO); float* Hg = Hu + 256 * 2 * 256;
            const PG8_LAS float* cw = (const PG8_LAS float*)(aux + 4096); PG8_LAS float* hx = (PG8_LAS float*)(aux + 8192);
            const f32x4 w0 = *(const PG8_LAS f32x4*)(cw + chg), w1 = *(const PG8_LAS f32x4*)(cw + 256 + chg), w2 = *(const PG8_LAS f32x4*)(cw + 512 + chg);
            if (fr >= 14) {
#pragma unroll
                for (int ai = 0; ai < 2; ++ai) { const float sc = scl[ai][3]; *(PG8_LAS f32x4*)(hx + (((2 * ai + wr) * 4 + wc) * 2 + (fr - 14)) * 16 + 4 * fq) = (acc[ai][1][3][0] * sc) * (acc[ai][0][3][0] * sc); } }
            asm volatile("s_waitcnt lgkmcnt(0)" ::: "memory"); __builtin_amdgcn_s_barrier(); asm volatile("" ::: "memory");
#pragma unroll
            for (int ai = 0; ai < 2; ++ai) {
                const int seg = 2 * ai + wr; f32x4 h1 = (f32x4){0.f, 0.f, 0.f, 0.f}, h2 = h1;
                if (seg > 0) { h2 = *(const PG8_LAS f32x4*)(hx + (((seg - 1) * 4 + wc) * 2 + 0) * 16 + 4 * fq); h1 = *(const PG8_LAS f32x4*)(hx + (((seg - 1) * 4 + wc) * 2 + 1) * 16 + 4 * fq); }
                f32x4 prv = (f32x4){0.f, 0.f, 0.f, 0.f};
#pragma unroll
                for (int m = 0; m < 4; ++m) {
                    const float sc = scl[ai][m]; const f32x4 cur = (acc[ai][1][m][0] * sc) * (acc[ai][0][m][0] * sc); f32x4 u1, u2;
#pragma unroll
                    for (int e2 = 0; e2 < 4; ++e2) {
                        const float c1 = __int_as_float(__builtin_amdgcn_update_dpp(0, __float_as_int(cur[e2]), 0x121, 0xf, 0xf, false)), c2 = __int_as_float(__builtin_amdgcn_update_dpp(0, __float_as_int(cur[e2]), 0x122, 0xf, 0xf, false));
                        float p1, p2;
                        if (m > 0) { const float pv_ = prv[e2]; p1 = __int_as_float(__builtin_amdgcn_update_dpp(0, __float_as_int(pv_), 0x121, 0xf, 0xf, false)); p2 = __int_as_float(__builtin_amdgcn_update_dpp(0, __float_as_int(pv_), 0x122, 0xf, 0xf, false)); }
                        else { p1 = h1[e2]; p2 = (fr == 1) ? h1[e2] : h2[e2]; }
                        u1[e2] = fr >= 1 ? c1 : p1; u2[e2] = fr >= 2 ? c2 : p2; }
                    const f32x4 dbv = acc[ai][0][m][1] * sc, dgv = acc[ai][1][m][1] * sc; f32x4 gg;
#pragma unroll
                    for (int e2 = 0; e2 < 4; ++e2) gg[e2] = dbv[e2] * dgv[e2] * __builtin_amdgcn_rcpf(1.0f + __builtin_amdgcn_exp2f(-1.4426950408889634f * dgv[e2]));
                    const f32x4 o = gg * (w0 * u2 + w1 * u1 + w2 * cur);
                    const size_t r = (size_t)(u.pm * BM + ai * HALF + wr * 64 + m * 16 + fr);
                    typedef unsigned u32x2 __attribute__((ext_vector_type(2)));
                    u32x2 w; w.x = cvt_pk_bf16(o[0], o[1]); w.y = cvt_pk_bf16(o[2], o[3]); *(PG8_GAS u32x2*)(Y + r * 1024 + 768 + chg) = w;
                    if (seg == 3 && m == 3 && fr >= 14) *(PG8_GAS f32x4*)(Hu + ((size_t)u.pm * 2 + (fr - 14)) * 256 + chg) = cur;
                    if (seg == 0 && m == 0 && fr < 2) *(PG8_GAS f32x4*)(Hg + ((size_t)u.pm * 2 + fr) * 256 + chg) = gg;
                    prv = cur;
                    __builtin_amdgcn_sched_barrier(0);
                }
            }
        }
    }
};

template <int K> __device__ __forceinline__ float row_shift(float cur, float prev, int fr) {
    const float a = __int_as_float(__builtin_amdgcn_update_dpp(0, __float_as_int(cur), 0x120 + K, 0xf, 0xf, false)), b = __int_as_float(__builtin_amdgcn_update_dpp(0, __float_as_int(prev), 0x120 + K, 0xf, 0xf, false));
    return fr >= K ? a : b;
}
struct EpiPool {
    static constexpr bool PERM = true, AFTER_DRAIN = false;
    bf16_t* P; int layer;
    __device__ __forceinline__ char* wsb() const { return (char*)P - WS_PROJ; }
    __device__ __forceinline__ void prefetch(PG8_LAS unsigned char* aux, const Unit& u, int ui, int wid, int lane) const {
        const float* ssq = (const float*)(wsb() + (layer == 0 ? WS_SSQ1 : WS_SSQ2));
        if (wid == 0) __builtin_amdgcn_global_load_lds((const unsigned*)(ssq + (size_t)u.pm * BM + lane * 4), (PG8_LAS unsigned*)(aux + (ui & 1) * 1024), 16, 0, 0);
    }
    __device__ __forceinline__ void operator()(const f32x4 (&acc)[2][2][4][2], const Unit& u, int wr, int wc, int fr_in, int fq_in, PG8_LAS unsigned char* aux, int ui) const {
        int fr = fr_in, fq = fq_in; asm volatile("" : "+v"(fr), "+v"(fq));
        const PG8_LAS float* rv = (const PG8_LAS float*)(aux + (ui & 1) * 1024);
        float scl[2][4];
#pragma unroll
        for (int ai = 0; ai < 2; ++ai)
#pragma unroll
            for (int m = 0; m < 4; ++m) scl[ai][m] = __builtin_amdgcn_rsqf(rv[ai * HALF + wr * 64 + m * 16 + fr] * (1.0f / 1024.0f) + 1e-6f);
        const int j = u.pn, grp = 2 * j + (wc >> 1), w = 2 << grp, chg = 128 * j + 32 * wc + 8 * fq;
        bf16_t* Y = (bf16_t*)(wsb() + WS_Y); float* Hpu = (float*)(wsb() + WS_PHALO); float* Hpg = Hpu + 256 * 16 * 256;
        PG8_LAS unsigned char* hx = aux + 8192;
#pragma unroll
        for (int ai = 0; ai < 2; ++ai) { const float sc = scl[ai][3]; const f32x4 v0 = acc[ai][0][3][0] * sc, v1 = acc[ai][0][3][1] * sc;
            u32x4 q; q.x = cvt_pk_bf16(v0[0], v0[1]); q.y = cvt_pk_bf16(v0[2], v0[3]); q.z = cvt_pk_bf16(v1[0], v1[1]); q.w = cvt_pk_bf16(v1[2], v1[3]);
            *(PG8_LAS u32x4*)(hx + ((2 * ai + wr) * 4 + wc) * 1024 + fr * 64 + fq * 16) = q; }
        asm volatile("s_waitcnt lgkmcnt(0)" ::: "memory"); __builtin_amdgcn_s_barrier(); asm volatile("" ::: "memory");
        const bool seqstart = (u.pm & 31) == 0;
#pragma unroll
        for (int ai = 0; ai < 2; ++ai) {
            const int seg = 2 * ai + wr; float hal[8];
            if (seg > 0) { const u32x4 q = *(const PG8_LAS u32x4*)(hx + ((seg - 1) * 4 + wc) * 1024 + fr * 64 + fq * 16);
                hal[0] = __uint_as_float(q.x << 16); hal[1] = __uint_as_float(q.x & 0xffff0000u); hal[2] = __uint_as_float(q.y << 16); hal[3] = __uint_as_float(q.y & 0xffff0000u);
                hal[4] = __uint_as_float(q.z << 16); hal[5] = __uint_as_float(q.z & 0xffff0000u); hal[6] = __uint_as_float(q.w << 16); hal[7] = __uint_as_float(q.w & 0xffff0000u); }
            else {
#pragma unroll
                for (int c8 = 0; c8 < 8; ++c8) hal[c8] = 0.f; }
            float S[4][8];
#pragma unroll
            for (int c8 = 0; c8 < 8; ++c8) {
                float x0 = hal[c8], x1 = acc[ai][0][0][c8 >> 2][c8 & 3] * scl[ai][0], x2 = acc[ai][0][1][c8 >> 2][c8 & 3] * scl[ai][1], x3 = acc[ai][0][2][c8 >> 2][c8 & 3] * scl[ai][2], x4 = acc[ai][0][3][c8 >> 2][c8 & 3] * scl[ai][3];
#define POOL_STEP(K) if (K < w) { x4 += row_shift<K>(x4, x3, fr); x3 += row_shift<K>(x3, x2, fr); x2 += row_shift<K>(x2, x1, fr); x1 += row_shift<K>(x1, x0, fr); x0 += row_shift<K>(x0, 0.f, fr); }
                POOL_STEP(1) POOL_STEP(2) POOL_STEP(4) POOL_STEP(8)
#undef POOL_STEP
                S[0][c8] = x1; S[1][c8] = x2; S[2][c8] = x3; S[3][c8] = x4; }
#pragma unroll
            for (int m = 0; m < 4; ++m) {
                const float sc = scl[ai][m]; const int t = 16 * m + fr;
                const float ic = (seqstart && seg == 0 && t < w - 1) ? __builtin_amdgcn_rcpf((float)(t + 1)) : __builtin_amdgcn_rcpf((float)w);
                float o[8], uu[8], gg[8];
#pragma unroll
                for (int c8 = 0; c8 < 8; ++c8) { uu[c8] = acc[ai][0][m][c8 >> 2][c8 & 3] * sc; const float gv = acc[ai][1][m][c8 >> 2][c8 & 3] * sc;
                    gg[c8] = gv * __builtin_amdgcn_rcpf(1.0f + __builtin_amdgcn_exp2f(-1.4426950408889634f * gv)); o[c8] = (S[m][c8] * ic - uu[c8]) * gg[c8]; }
                const size_t r = (size_t)(u.pm * BM + ai * HALF + wr * 64 + m * 16 + fr);
                u32x4 q; q.x = cvt_pk_bf16(o[0], o[1]); q.y = cvt_pk_bf16(o[2], o[3]); q.z = cvt_pk_bf16(o[4], o[5]); q.w = cvt_pk_bf16(o[6], o[7]);
                *(PG8_GAS u32x4*)(Y + r * 1024 + 256 + chg) = q;
                if (seg == 3 && m == 3) { float* hp = Hpu + ((size_t)u.pm * 16 + fr) * 256 + chg; *(PG8_GAS f32x4*)hp = (f32x4){uu[0], uu[1], uu[2], uu[3]}; *(PG8_GAS f32x4*)(hp + 4) = (f32x4){uu[4], uu[5], uu[6], uu[7]}; }
                if (seg == 0 && m == 0) { float* hp = Hpg + ((size_t)u.pm * 16 + fr) * 256 + chg; *(PG8_GAS f32x4*)hp = (f32x4){gg[0], gg[1], gg[2], gg[3]}; *(PG8_GAS f32x4*)(hp + 4) = (f32x4){gg[4], gg[5], gg[6], gg[7]}; }
                __builtin_amdgcn_sched_barrier(0);
            }
        }
    }
};

struct EpiPoolConv {
    static constexpr bool PERM = true, AFTER_DRAIN = false;
    bf16_t* P; int layer;
    __device__ __forceinline__ void prefetch(PG8_LAS unsigned char* aux, const Unit& u, int ui, int wid, int lane) const { EpiPool E{P, layer}; E.prefetch(aux, u, ui, wid, lane); }
    __device__ __forceinline__ void operator()(const f32x4 (&acc)[2][2][4][2], const Unit& u, int wr, int wc, int fr, int fq, PG8_LAS unsigned char* aux, int ui) const {
        if (u.pn < 2) { EpiPool E{P, layer}; E(acc, u, wr, wc, fr, fq, aux, ui); }
        else { EpiConv E{P, layer}; Unit v = u; v.pn = u.pn - 2; E(acc, v, wr, wc, fr, fq, aux, ui); }
    }
};

struct EpiInAll {
    static constexpr bool PERM = true, AFTER_DRAIN = false;
    bf16_t* P; int layer; int do_km;
    __device__ __forceinline__ void prefetch(PG8_LAS unsigned char* aux, const Unit& u, int ui, int wid, int lane) const { EpiPool E{P, layer}; E.prefetch(aux, u, ui, wid, lane); }
    __device__ __forceinline__ void operator()(const f32x4 (&acc)[2][2][4][2], const Unit& u, int wr, int wc, int fr, int fq, PG8_LAS unsigned char* aux, int ui) const {
        if (u.pn < 7) { EpiInProj E{P, layer, do_km}; E(acc, u, wr, wc, fr, fq, aux, ui); }
        else if (u.pn < 9) { EpiPool E{P, layer}; Unit v = u; v.pn = u.pn - 7; E(acc, v, wr, wc, fr, fq, aux, ui); }
        else { EpiConv E{P, layer}; Unit v = u; v.pn = u.pn - 9; E(acc, v, wr, wc, fr, fq, aux, ui); }
    }
};
struct EpiOutProj {
    static constexpr bool PERM = true, AFTER_DRAIN = false;
    const bf16_t* xin_b; float* xout; bf16_t* xb; float* ssq;
    __device__ __forceinline__ void prefetch(PG8_LAS unsigned char*, const Unit&, int, int, int) const {}
    __device__ __forceinline__ f32x4 xch(const f32x4 give) const { f32x4 r;
#pragma unroll
        for (int e = 0; e < 4; ++e) r[e] = __int_as_float(__builtin_amdgcn_update_dpp(0, __float_as_int(give[e]), 0x128, 0xf, 0xf, false));
        return r; }
    __device__ __forceinline__ void operator()(const f32x4 (&acc)[2][2][4][2], const Unit& u, int wr, int wc, int fr_in, int fq_in, PG8_LAS unsigned char*, int) const {
        int fr = fr_in, fq = fq_in; asm volatile("" : "+v"(fr), "+v"(fq));
        const int col0 = u.pn * BM + wc * 32 + 8 * fq; const bool lo8 = fr < 8; const int cpart = lo8 ? 0 : 4;
        u32x4 rb[2][4][2];
#pragma unroll
        for (int ai = 0; ai < 2; ++ai)
#pragma unroll
            for (int m = 0; m < 4; ++m)
#pragma unroll
                for (int bj = 0; bj < 2; ++bj) rb[ai][m][bj] = __builtin_nontemporal_load((const PG8_GAS u32x4*)(xin_b + (size_t)(u.pm * BM + ai * HALF + wr * 64 + m * 16 + fr) * 1024 + col0 + bj * HALF));
#pragma unroll
        for (int ai = 0; ai < 2; ++ai)
#pragma unroll
            for (int m = 0; m < 4; ++m) {
                const int rg = u.pm * BM + ai * HALF + wr * 64 + m * 16; const int r = rg + fr; const size_t off = (size_t)r * 1024 + col0; float ss = 0.f;
                const size_t offA = (size_t)(rg + (fr & 7)) * 1024 + col0 + cpart, offB = offA + 8 * 1024;
#pragma unroll
                for (int bj = 0; bj < 2; ++bj) { const u32x4 q = rb[ai][m][bj];
                    const f32x4 r0 = (f32x4){__uint_as_float(q.x << 16), __uint_as_float(q.x & 0xffff0000u), __uint_as_float(q.y << 16), __uint_as_float(q.y & 0xffff0000u)};
                    const f32x4 r1 = (f32x4){__uint_as_float(q.z << 16), __uint_as_float(q.z & 0xffff0000u), __uint_as_float(q.w << 16), __uint_as_float(q.w & 0xffff0000u)};
                    const f32x4 v0 = acc[ai][bj][m][0] + r0, v1 = acc[ai][bj][m][1] + r1;
                    if (xout) { const f32x4 rc = xch(lo8 ? v1 : v0); const f32x4 s1 = lo8 ? v0 : rc, s2 = lo8 ? rc : v1;
                        __builtin_nontemporal_store(s1, (PG8_GAS f32x4*)(xout + offA + bj * HALF)); __builtin_nontemporal_store(s2, (PG8_GAS f32x4*)(xout + offB + bj * HALF)); }
                    if (xb) { u32x4 w; w.x = cvt_pk_bf16(v0[0], v0[1]); w.y = cvt_pk_bf16(v0[2], v0[3]); w.z = cvt_pk_bf16(v1[0], v1[1]); w.w = cvt_pk_bf16(v1[2], v1[3]); *(PG8_GAS u32x4*)(xb + off + bj * HALF) = w;
                        const f32x4 q0 = v0 * v0, q1 = v1 * v1; ss += ((q0[0] + q0[1]) + (q0[2] + q0[3])) + ((q1[0] + q1[1]) + (q1[2] + q1[3])); } }
                if (xb) { ss += __shfl_xor(ss, 16); ss += __shfl_xor(ss, 32); if (fq == 0) __hip_atomic_fetch_add((PG8_GAS float*)(ssq + r), ss, __ATOMIC_RELAXED, __HIP_MEMORY_SCOPE_AGENT); }
            }
    }
};

struct EpiNull {
    static constexpr bool PERM = true, AFTER_DRAIN = false;
    __device__ __forceinline__ void prefetch(PG8_LAS unsigned char*, const Unit&, int, int, int) const {}
    __device__ __forceinline__ void operator()(const f32x4 (&acc)[2][2][4][2], const Unit& u, int wr, int wc, int fr, int fq, PG8_LAS unsigned char*, int) const {
#pragma unroll
        for (int ai = 0; ai < 2; ++ai)
#pragma unroll
            for (int bj = 0; bj < 2; ++bj)
#pragma unroll
                for (int m = 0; m < 4; ++m)
#pragma unroll
                    for (int n = 0; n < 2; ++n) asm volatile("" :: "v"(acc[ai][bj][m][n]));
    }
};
struct EpiPlain {
    static constexpr bool PERM = true, AFTER_DRAIN = false;
    bf16_t* P; int ldc;
    __device__ __forceinline__ void prefetch(PG8_LAS unsigned char*, const Unit&, int, int, int) const {}
    __device__ __forceinline__ void operator()(const f32x4 (&acc)[2][2][4][2], const Unit& u, int wr, int wc, int fr, int fq, PG8_LAS unsigned char*, int) const {
        const int lcol = u.pn * 256 + 64 * wc + 8 * fq;
#pragma unroll
        for (int bj = 0; bj < 2; ++bj)
#pragma unroll
            for (int ai = 0; ai < 2; ++ai)
#pragma unroll
                for (int m = 0; m < 4; ++m) { const int r = u.pm * BM + ai * HALF + wr * 64 + m * 16 + fr; const f32x4 v0 = acc[ai][bj][m][0], v1 = acc[ai][bj][m][1];
                    u32x4 w; w.x = cvt_pk_bf16(v0[0], v0[1]); w.y = cvt_pk_bf16(v0[2], v0[3]); w.z = cvt_pk_bf16(v1[0], v1[1]); w.w = cvt_pk_bf16(v1[2], v1[3]);
                    *(PG8_GAS u32x4*)(P + (size_t)r * ldc + lcol + 32 * bj) = w; }
    }
};
template <class Epi, class Sched, bool ALIGN_EPI = false, bool SP2 = false>
__device__ __forceinline__ void gemm_phase(PG8_LAS unsigned char* lds, PG8_LAS unsigned char* aux, const Gemm g, const Sched& S, const Epi& E) {
    int tid_ = threadIdx.x; asm volatile("" : "+v"(tid_));
    const int tid = tid_, wid = __builtin_amdgcn_readfirstlane(tid >> 6), lane = tid & 63, wr = wid >> 2, wc = wid & 3, fr = lane & 15, fq = lane >> 4;
    const int K = g.K, nt = K / BK;
    unsigned voffA[2], voffB[2];
#pragma unroll
    for (int i = 0; i < 2; ++i) { int R, C; stage_rc(tid * 16 + i * 8192, R, C); const int Rb = Epi::PERM ? ((R & ~31) + perm32(R & 31)) : R;
        voffA[i] = (unsigned)(R * K + C) * 2u; voffB[i] = (unsigned)(Rb * K + C) * 2u; }
    const size_t kstep = (size_t)(BK * 2);
    const size_t hstep = (size_t)HALF * K * 2;
    const size_t tstep = 2 * hstep;
    const unsigned ldsw = (unsigned)wid * 1024u;
    const int aoff = lds_byte(wr * 64 + fr, fq * 8), boff = lds_byte(wc * 32 + fr, fq * 8);
#define PG8_SA(b, h) (((b) * 2 + (h)) * HTB)
#define PG8_SB(b, h) ((4 + (b) * 2 + (h)) * HTB)
#define PG8_STAGE(bufoff, gbase, voff) do { _Pragma("unroll") for (int _i = 0; _i < 2; ++_i) \
        __builtin_amdgcn_global_load_lds((const unsigned*)((const char*)(gbase) + (voff)[_i]), (PG8_LAS unsigned*)(lds + (bufoff) + ldsw + _i * 8192), 16, 0, 0); } while (0)
#define PG8_LDA(dst, b, h) do { _Pragma("unroll") for (int m = 0; m < 4; ++m) _Pragma("unroll") for (int k = 0; k < 2; ++k) dst[m][k] = *(const PG8_LAS bf16x8*)(lds + PG8_SA(b, h) + aoff + m * 2048 + k * 1024); } while (0)
#define PG8_LDB(dst, b, h) do { _Pragma("unroll") for (int n = 0; n < 2; ++n) _Pragma("unroll") for (int k = 0; k < 2; ++k) dst[n][k] = *(const PG8_LAS bf16x8*)(lds + PG8_SB(b, h) + boff + n * 2048 + k * 1024); } while (0)
#define PG8_MMA(ai, bj, At, Bt) do { __builtin_amdgcn_s_setprio(1); _Pragma("unroll") for (int m = 0; m < 4; ++m) _Pragma("unroll") for (int n = 0; n < 2; ++n) _Pragma("unroll") for (int k = 0; k < 2; ++k) \
        acc[ai][bj][m][n] = __builtin_amdgcn_mfma_f32_16x16x32_bf16(Bt[n][k], At[m][k], acc[ai][bj][m][n], 0, 0, 0); __builtin_amdgcn_s_setprio(0); } while (0)
#define PG8_WAIT_V(n) asm volatile("s_waitcnt vmcnt(" #n ")" ::: "memory")
#define PG8_WAIT_L(n) asm volatile("s_waitcnt lgkmcnt(" #n ")" ::: "memory")
#define PG8_BAR __builtin_amdgcn_s_barrier()
#define PG8_SCHED __builtin_amdgcn_sched_barrier(0)
    Unit cur, nxt; int ui = 0;
    if (!S.next(0, cur)) return;
    f32x4 acc[2][2][4][2];
#pragma unroll
    for (int a = 0; a < 2; ++a)
#pragma unroll
        for (int b = 0; b < 2; ++b)
#pragma unroll
            for (int m = 0; m < 4; ++m)
#pragma unroll
                for (int n = 0; n < 2; ++n) acc[a][b][m][n] = (f32x4){0.f, 0.f, 0.f, 0.f};
    bf16x8 At[4][2], B0[2][2], B1[2][2];
    const char* cA = (const char*)g.A + (size_t)cur.pm * tstep; const char* cB = (const char*)g.Bt + (size_t)cur.pn * tstep;
    S.a_ready(cur); E.prefetch(aux, cur, 0, wid, lane);
    if constexpr (SP2) {
        PG8_STAGE(PG8_SB(0, 0), cB, voffB); PG8_STAGE(PG8_SB(0, 1), cB + hstep, voffB); PG8_STAGE(PG8_SA(0, 0), cA, voffA); PG8_STAGE(PG8_SA(0, 1), cA + hstep, voffA);
        if (wr == 1) PG8_BAR;
        PG8_WAIT_V(2); PG8_BAR;
        PG8_STAGE(PG8_SB(1, 0), cB + kstep, voffB); PG8_STAGE(PG8_SA(1, 0), cA + kstep, voffA); PG8_STAGE(PG8_SB(1, 1), cB + hstep + kstep, voffB);
        PG8_WAIT_V(6); PG8_BAR;
    } else {
        PG8_STAGE(PG8_SB(0, 0), cB, voffB); PG8_STAGE(PG8_SA(0, 0), cA, voffA); PG8_STAGE(PG8_SB(0, 1), cB + hstep, voffB); PG8_STAGE(PG8_SA(0, 1), cA + hstep, voffA);
        if (wr == 1) PG8_BAR;
        PG8_WAIT_V(4); PG8_BAR;
        PG8_STAGE(PG8_SB(1, 0), cB + kstep, voffB); PG8_STAGE(PG8_SA(1, 0), cA + kstep, voffA); PG8_STAGE(PG8_SB(1, 1), cB + hstep + kstep, voffB);
        PG8_WAIT_V(6); PG8_BAR;
    }
    for (;;) {
        const bool has_next = S.next(ui + 1, nxt);
        const char* nA = has_next ? (const char*)g.A + (size_t)nxt.pm * tstep : cA; const char* nB = has_next ? (const char*)g.Bt + (size_t)nxt.pn * tstep : cB;
        for (int t = 0; t < nt; t += 2) {
            const bool last = (t == nt - 2);
            const char* a1 = cA + (size_t)(t + 1) * kstep;
            const char* a2 = last ? nA : cA + (size_t)(t + 2) * kstep; const char* b2 = last ? nB : cB + (size_t)(t + 2) * kstep;
            const char* a3 = a2 + kstep; const char* b3 = b2 + kstep;
            if (last && has_next) { S.a_ready(nxt); E.prefetch(aux, nxt, ui + 1, wid, lane); }
            if constexpr (SP2) {
            PG8_LDB(B0, 0, 0); PG8_LDB(B1, 0, 1); PG8_SCHED; PG8_LDA(At, 0, 0); PG8_STAGE(PG8_SA(1, 1), a1 + hstep, voffA);
            PG8_WAIT_V(8); PG8_WAIT_L(0); PG8_BAR; PG8_MMA(0, 0, At, B0); PG8_MMA(0, 1, At, B1); PG8_BAR; PG8_SCHED;
            PG8_LDA(At, 0, 1); PG8_STAGE(PG8_SB(0, 0), b2, voffB); PG8_STAGE(PG8_SB(0, 1), b2 + hstep, voffB); PG8_STAGE(PG8_SA(0, 0), a2, voffA);
            PG8_WAIT_V(8); PG8_WAIT_L(0); PG8_BAR; PG8_MMA(1, 0, At, B0); PG8_MMA(1, 1, At, B1); PG8_BAR; PG8_SCHED;
            PG8_LDB(B0, 1, 0); PG8_LDB(B1, 1, 1); PG8_SCHED; PG8_LDA(At, 1, 0); PG8_STAGE(PG8_SA(0, 1), a2 + hstep, voffA);
            PG8_WAIT_V(8); PG8_WAIT_L(0); PG8_BAR; PG8_MMA(0, 0, At, B0); PG8_MMA(0, 1, At, B1); PG8_BAR; PG8_SCHED;
            PG8_LDA(At, 1, 1); PG8_STAGE(PG8_SB(1, 0), b3, voffB); PG8_STAGE(PG8_SB(1, 1), b3 + hstep, voffB); PG8_STAGE(PG8_SA(1, 0), a3, voffA);
            PG8_WAIT_V(8); PG8_WAIT_L(0); PG8_BAR; PG8_MMA(1, 0, At, B0); PG8_MMA(1, 1, At, B1); PG8_BAR; PG8_SCHED;
            } else {
            PG8_LDB(B0, 0, 0); PG8_SCHED; PG8_LDA(At, 0, 0); PG8_STAGE(PG8_SA(1, 1), a1 + hstep, voffA);
            PG8_WAIT_L(8); PG8_BAR; PG8_WAIT_L(0); PG8_MMA(0, 0, At, B0); PG8_BAR; PG8_SCHED;
            PG8_LDB(B1, 0, 1); PG8_STAGE(PG8_SB(0, 0), b2, voffB);
            PG8_BAR; PG8_WAIT_L(0); PG8_MMA(0, 1, At, B1); PG8_BAR;
            PG8_LDA(At, 0, 1); PG8_STAGE(PG8_SA(0, 0), a2, voffA);
            PG8_BAR; PG8_WAIT_L(0); PG8_MMA(1, 0, At, B0); PG8_BAR; PG8_SCHED;
            PG8_STAGE(PG8_SB(0, 1), b2 + hstep, voffB);
            PG8_WAIT_V(6); PG8_BAR; PG8_MMA(1, 1, At, B1); PG8_BAR;
            PG8_LDB(B0, 1, 0); PG8_SCHED; PG8_LDA(At, 1, 0); PG8_STAGE(PG8_SA(0, 1), a2 + hstep, voffA);
            PG8_WAIT_L(8); PG8_BAR; PG8_WAIT_L(0); PG8_MMA(0, 0, At, B0); PG8_BAR; PG8_SCHED;
            PG8_LDB(B1, 1, 1); PG8_STAGE(PG8_SB(1, 0), b3, voffB);
            PG8_BAR; PG8_WAIT_L(0); PG8_MMA(0, 1, At, B1); PG8_BAR;
            PG8_LDA(At, 1, 1); PG8_STAGE(PG8_SA(1, 0), a3, voffA);
            PG8_BAR; PG8_WAIT_L(0); PG8_MMA(1, 0, At, B0); PG8_BAR; PG8_SCHED;
            PG8_STAGE(PG8_SB(1, 1), b3 + hstep, voffB);
            PG8_WAIT_V(6); PG8_BAR; PG8_MMA(1, 1, At, B1); PG8_BAR;
            }
        }
        if constexpr (ALIGN_EPI) { if (wr == 0) PG8_BAR; }
        if constexpr (!Epi::AFTER_DRAIN) { E(acc, cur, wr, wc, fr, fq, aux, ui); S.done(cur); }
        if (!has_next) break;
#pragma unroll
        for (int a = 0; a < 2; ++a)
#pragma unroll
            for (int b = 0; b < 2; ++b)
#pragma unroll
                for (int m = 0; m < 4; ++m)
#pragma unroll
                    for (int n = 0; n < 2; ++n) acc[a][b][m][n] = (f32x4){0.f, 0.f, 0.f, 0.f};
        cur = nxt; cA = nA; cB = nB; ++ui;
        if constexpr (ALIGN_EPI) { if (wr == 1) PG8_BAR; }
    }
    PG8_WAIT_V(0);
    if constexpr (!ALIGN_EPI) { if (wr == 0) PG8_BAR; }
    PG8_BAR;
    if constexpr (Epi::AFTER_DRAIN) { E.fused(acc, cur, wr, wc, fr, fq, lds, wid, lane); S.done(cur); }
#undef PG8_SA
#undef PG8_SB
#undef PG8_STAGE
#undef PG8_LDA
#undef PG8_LDB
#undef PG8_MMA
#undef PG8_WAIT_V
#undef PG8_WAIT_L
#undef PG8_BAR
#undef PG8_SCHED
}
}
#define GAS __attribute__((address_space(1)))
#define LAS __attribute__((address_space(3)))
typedef unsigned short bf16;
typedef unsigned v4u __attribute__((ext_vector_type(4)));
typedef float f32x4 __attribute__((ext_vector_type(4)));
typedef short bf16x8 __attribute__((ext_vector_type(8)));
typedef GAS unsigned gu32;
typedef GAS unsigned long long gu64;
#define RLX_AGENT __ATOMIC_RELAXED, __HIP_MEMORY_SCOPE_AGENT
#define LDS_WAIT() asm volatile("s_waitcnt lgkmcnt(0)" ::: "memory")
#define VM_WAIT() asm volatile("s_waitcnt vmcnt(0)" ::: "memory")
__device__ __forceinline__ unsigned long long rt() { return __builtin_amdgcn_s_memrealtime(); }
__device__ __forceinline__ unsigned f2bf(float f) { unsigned u = __builtin_bit_cast(unsigned, f); return (u + 0x7fffu + ((u >> 16) & 1u)) >> 16; }
__device__ __forceinline__ unsigned pk2(float lo, float hi) { return f2bf(lo) | (f2bf(hi) << 16); }

#define XB_TMO      128
#define XB_XCNT(j)  (256  + 64 * (j))
#define XB_XSUB(j)  (1280 + 64 * (j))
#define XB_XGEN(j)  (2304 + 64 * (j))
#define XB_TOP      3328
#define XB_TOPGEN   3392
#define XCD_BAR_WORDS 3456
#define XB_SPIN_CAP (1u << 18)

__device__ __forceinline__ unsigned xb_ld(unsigned* p)              { return __hip_atomic_load(p, __ATOMIC_RELAXED, __HIP_MEMORY_SCOPE_AGENT); }
__device__ __forceinline__ unsigned xb_add(unsigned* p, unsigned v) { return __hip_atomic_fetch_add(p, v, __ATOMIC_RELAXED, __HIP_MEMORY_SCOPE_AGENT); }
__device__ __forceinline__ unsigned xb_xcc_id() { return (unsigned)__builtin_amdgcn_s_getreg((3 << 11) | 20) & 0xFu; }
#define XB_SPIN(cond, bar) do { unsigned _sp = 0; while (cond) { __builtin_amdgcn_s_sleep(1); \
    if ((++_sp & 255u) == 0u) { if (xb_ld(&(bar)[XB_TMO])) break; if (_sp > XB_SPIN_CAP) { atomicAdd(&(bar)[XB_TMO], 1u); break; } } } } while (0)

struct XcdBarrier {
    unsigned* bar; unsigned x;
    volatile LAS unsigned* st;
};

__device__ __forceinline__ XcdBarrier xcd_barrier_post(unsigned* bar, volatile LAS unsigned* st) {
    XcdBarrier b; b.bar = bar; b.x = xb_xcc_id(); b.st = st;
    if (threadIdx.x == 0) (void)xb_add(&bar[XB_XCNT(b.x)], 1u);
    return b;
}
__device__ __forceinline__ void xcd_barrier_complete(unsigned* bar, unsigned x, unsigned& nloc, unsigned& nx) {
    const unsigned G = gridDim.x * gridDim.y * gridDim.z;
    unsigned sum, cnt, mine, sp = 0u;
    for (;;) {
        sum = 0u; cnt = 0u; mine = 0u;
#pragma unroll
        for (unsigned j = 0; j < 16; ++j) { const unsigned c = xb_ld(&bar[XB_XCNT(j)]); sum += c; cnt += (c > 0u) ? 1u : 0u; mine = (j == x) ? c : mine; }
        if (sum == G) break;
        __builtin_amdgcn_s_sleep(1);
        if ((++sp & 255u) == 0u) { if (xb_ld(&bar[XB_TMO])) break; if (sp > XB_SPIN_CAP) { atomicAdd(&bar[XB_TMO], 1u); break; } }
    }
    nloc = mine > 0u ? mine : 1u; nx = cnt > 0u ? cnt : 1u;
}

__device__ __forceinline__ void xcd_barrier(const XcdBarrier& b) {
    asm volatile("s_waitcnt vmcnt(0)" ::: "memory");
    __syncthreads();
    if (threadIdx.x == 0) {
        unsigned* bar = b.bar;
        __builtin_amdgcn_s_waitcnt(0);
        unsigned nloc = b.st[0], nx = b.st[1];
        if (nloc == 0u) { xcd_barrier_complete(bar, b.x, nloc, nx); b.st[0] = nloc; b.st[1] = nx; }
        const unsigned old = xb_add(&bar[XB_XSUB(b.x)], 1u);
        const unsigned gen = old / nloc;
        if (old + 1u == (gen + 1u) * nloc) {
            __builtin_amdgcn_fence(__ATOMIC_RELEASE, "agent");
            asm volatile("s_waitcnt vmcnt(0)" ::: "memory");
            const unsigned og = xb_add(&bar[XB_TOP], 1u);
            const unsigned tg = og / nx;
            if (og + 1u == (tg + 1u) * nx) xb_add(&bar[XB_TOPGEN], 1u);
            else XB_SPIN(xb_ld(&bar[XB_TOPGEN]) == tg, bar);
            __builtin_amdgcn_fence(__ATOMIC_ACQUIRE, "agent");
            xb_add(&bar[XB_XGEN(b.x)], 1u);
            asm volatile("s_waitcnt vmcnt(0)" ::: "memory");
        } else {
            XB_SPIN(xb_ld(&bar[XB_XGEN(b.x)]) == gen, bar);
            __builtin_amdgcn_fence(__ATOMIC_ACQUIRE, "agent");
            asm volatile("s_waitcnt vmcnt(0)" ::: "memory");
        }
    }
    __syncthreads();
}

#define GB_CNT 0
#define GB_GEN 512
#define GB_MASK 1024
constexpr unsigned GRP_N = 32;
struct GrpBarrier { unsigned* w; unsigned* bar; volatile LAS unsigned* st; };
__device__ __forceinline__ void grp_barrier_post(const GrpBarrier& b) { if (threadIdx.x == 0) (void)__hip_atomic_fetch_or(b.w + GB_MASK, 1u << xb_xcc_id(), __ATOMIC_RELAXED, __HIP_MEMORY_SCOPE_AGENT); }
__device__ __forceinline__ void grp_barrier(const GrpBarrier& b) {
    asm volatile("s_waitcnt vmcnt(0)" ::: "memory");
    __syncthreads();
    if (threadIdx.x == 0) {
        __builtin_amdgcn_s_waitcnt(0);
        unsigned mode = b.st[0];
        if (mode == 0u) { const unsigned m = xb_ld(b.w + GB_MASK); mode = (__builtin_popcount(m) == 1) ? 1u : 2u; b.st[0] = mode; }
        if (mode != 1u) { __builtin_amdgcn_fence(__ATOMIC_RELEASE, "agent"); asm volatile("s_waitcnt vmcnt(0)" ::: "memory"); }
        const unsigned old = xb_add(b.w + GB_CNT, 1u); const unsigned gen = old / GRP_N;
        if (old + 1u == (gen + 1u) * GRP_N) xb_add(b.w + GB_GEN, 1u);
        else XB_SPIN(xb_ld(b.w + GB_GEN) == gen, b.bar);
        __builtin_amdgcn_fence(__ATOMIC_ACQUIRE, "agent");
        asm volatile("s_waitcnt vmcnt(0)" ::: "memory");
    }
    __syncthreads();
}
namespace moba_body {
typedef unsigned short bf16;
using bf16x8=__attribute__((ext_vector_type(8)))short;
using s16x4=__attribute__((ext_vector_type(4)))short;
using f32x16=__attribute__((ext_vector_type(16)))float;
using f32x4=__attribute__((ext_vector_type(4)))float;
using u32x4=__attribute__((ext_vector_type(4)))unsigned;
#define MB_GAS __attribute__((address_space(1)))
#define MB_LAS __attribute__((address_space(3)))
constexpr int D=64,NHEAD=4,PITCH=NPROJ,YPITCH=DM;
constexpr int NW=8,QBLK=32,QB=QBLK*NW,KVBLK=64,NQB=SEQ/QB;
__device__ __forceinline__ int crow(int r,int hi){return (r&3)+8*(r>>2)+4*hi;}
#define SBAR() __builtin_amdgcn_sched_barrier(0)
__device__ __forceinline__ void cmask(f32x16&p0,f32x16&p1,int jb,int qrel,int hi){
  const float NEG=-INFINITY; int kb=64*jb+4*hi;
  #pragma unroll
  for(int r=0;r<16;++r){int kv=kb+(r&3)+8*(r>>2); if(kv>qrel)p0[r]=NEG; if(kv+32>qrel)p1[r]=NEG;}
}
constexpr int NSLOT=3, SLOTB=8192;
constexpr int LDS_K=0, LDS_V=NSLOT*SLOTB, LDS_WS=2*NSLOT*SLOTB, LDS_OST=LDS_WS+NW*64*4, LDS_BYTES=LDS_OST+NW*4096;
constexpr float LOG2E=1.4426950408889634f;
__device__ __forceinline__ void glds16(const void*gsrc,unsigned lds_dst){unsigned keep;
  asm volatile("s_mov_b32 %0, m0\n\ts_mov_b32 m0, %2\n\ts_nop 0\n\tglobal_load_lds_dwordx4 %1, off\n\ts_mov_b32 m0, %0":"=&s"(keep):"v"(gsrc),"s"(lds_dst):"memory");}
typedef float f32x2_t __attribute__((ext_vector_type(2))); typedef __bf16 bf16x2_t __attribute__((ext_vector_type(2)));
__device__ __forceinline__ unsigned cvtpk_s(float lo,float hi){f32x2_t v={lo,hi};bf16x2_t b=__builtin_convertvector(v,bf16x2_t);return __builtin_bit_cast(unsigned,b);}
__device__ __forceinline__ float bfround(float x){ return __uint_as_float(cvtpk_s(x,0.f)<<16); }
#define WAIT_BAR(N) asm volatile("s_waitcnt vmcnt(" #N ") lgkmcnt(0)\n\ts_barrier":::"memory")
#define MFMA32(a,b,c) __builtin_amdgcn_mfma_f32_32x32x16_bf16(a,b,c,0,0,0)
typedef __attribute__((address_space(3))) const char* lds_cptr;
typedef short v4i16_t __attribute__((ext_vector_type(4)));
__device__ __forceinline__ void kload8(bf16x8*kf,lds_cptr kp){
  kf[0]=*(const __attribute__((address_space(3))) bf16x8*)(kp);      kf[1]=*(const __attribute__((address_space(3))) bf16x8*)(kp+512);
  kf[2]=*(const __attribute__((address_space(3))) bf16x8*)(kp+2048); kf[3]=*(const __attribute__((address_space(3))) bf16x8*)(kp+2560);
  kf[4]=*(const __attribute__((address_space(3))) bf16x8*)(kp+4096); kf[5]=*(const __attribute__((address_space(3))) bf16x8*)(kp+4608);
  kf[6]=*(const __attribute__((address_space(3))) bf16x8*)(kp+6144); kf[7]=*(const __attribute__((address_space(3))) bf16x8*)(kp+6656);
}
__device__ __forceinline__ void kload2(bf16x8*kf,lds_cptr kp,int j){ kf[2*j]=*(const __attribute__((address_space(3))) bf16x8*)(kp+j*2048); kf[2*j+1]=*(const __attribute__((address_space(3))) bf16x8*)(kp+j*2048+512); }
__device__ __forceinline__ s16x4 vtr(lds_cptr p){ return __builtin_bit_cast(s16x4,__builtin_amdgcn_ds_read_tr16_b64_v4i16((__attribute__((address_space(3))) v4i16_t*)p)); }
#define MX3(a,b,c) __builtin_fmaxf(__builtin_fmaxf((a),(b)),(c))
__device__ __forceinline__ float rowmax(const f32x16&p0,const f32x16&p1){
  float a=MX3(p0[0],p0[1],p1[0]),b=MX3(p0[2],p0[3],p1[1]);a=MX3(a,p1[2],p1[3]);
  #pragma unroll
  for(int r=4;r<16;r+=4){a=MX3(a,p0[r],p0[r+1]);b=MX3(b,p0[r+2],p0[r+3]);a=MX3(a,p1[r],p1[r+1]);b=MX3(b,p1[r+2],p1[r+3]);}
  const float m=__builtin_fmaxf(a,b);
  auto rr=__builtin_amdgcn_permlane32_swap(__float_as_uint(m),__float_as_uint(m),false,false);
  return __builtin_fmaxf(__uint_as_float(rr[0]),__uint_as_float(rr[1]));
}
__device__ __forceinline__ void pv(f32x16*o,int vb,bf16x8 pa0,bf16x8 pa1,bf16x8 pa2,bf16x8 pa3){
  #pragma unroll
  for(int d0=0;d0<2;++d0){s16x4 lo[4],hi[4];
    #pragma unroll
    for(int ks=0;ks<4;++ks){
      asm volatile("ds_read_b64_tr_b16 %0,%1 offset:%c2":"=&v"(lo[ks]):"v"(vb),"i"(d0*4096+ks*1024):"memory");
      asm volatile("ds_read_b64_tr_b16 %0,%1 offset:%c2":"=&v"(hi[ks]):"v"(vb),"i"(d0*4096+ks*1024+512):"memory");}
    asm volatile("s_waitcnt lgkmcnt(0)":::"memory");SBAR();
    #define PK(k) (bf16x8){lo[k][0],lo[k][1],lo[k][2],lo[k][3],hi[k][0],hi[k][1],hi[k][2],hi[k][3]}
    o[d0]=MFMA32(pa0,PK(0),o[d0]);
    o[d0]=MFMA32(pa1,PK(1),o[d0]);
    o[d0]=MFMA32(pa2,PK(2),o[d0]);
    o[d0]=MFMA32(pa3,PK(3),o[d0]);
    #undef PK
  }
}
template<int NT,int MODE> __device__ __forceinline__ void chunk_attn(f32x16*o,float&l,const bf16x8*qr,u32x4&ka,const u32x4&qa0,const u32x4&qa1,unsigned hm,float dTb,lds_cptr kp0,lds_cptr vp0,int tile0,int r32,int hi,int qd){
  #define CK_SETDT(t) do{ const float d_=dTb+(float)(64*(tile0+(t))); ka[1]=cvtpk_s(d_,d_)&hm; }while(0)
  #define CK_KA __builtin_bit_cast(bf16x8,ka)
  #define CK_MASK(C0,C1,t) do{ if(MODE==1&&(t)==NT-1){ _Pragma("unroll") for(int r=0;r<16;++r){ const int kv=crow(r,hi); if(kv>qd)C0[r]=-INFINITY; if(kv+32>qd)C1[r]=-INFINITY; } } \
      if(MODE==2){ const int kb_=64*(tile0+(t)); _Pragma("unroll") for(int r=0;r<16;++r){ const int kk=kb_+crow(r,hi); if(kk>qd||kk<qd-127)C0[r]=-INFINITY; if(kk+32>qd||kk+32<qd-127)C1[r]=-INFINITY; } } }while(0)
  bf16x8 kf[8]; s16x4 vlo[8],vhi[8]; u32x4 pw0,pw1,pw2,pw3; f32x16 pA0,pA1,pB0,pB1;
  #define PKW(P,B) cvtpk_s(P[B],P[B+1])
  #define PAF(k) __builtin_bit_cast(bf16x8,pw##k)
  #define VFR(i) (bf16x8){vlo[i][0],vlo[i][1],vlo[i][2],vlo[i][3],vhi[i][0],vhi[i][1],vhi[i][2],vhi[i][3]}
  #define PIN(x) asm volatile("":"+v"(x))
  #define GAPA(MF,A0,A1,A2,A3,W0,W1,PW) do{ MF; sacc+=A0; sacc+=A1; sacc+=A2; sacc+=A3; PIN(sacc); W0; W1; PIN(PW); SBAR(); }while(0)
  #define EX(v) __builtin_amdgcn_exp2f(v)
  #define GAPB(MF,X,B) do{ MF; X[B]=EX(X[B]); X[B+1]=EX(X[B+1]); X[B+2]=EX(X[B+2]); X[B+3]=EX(X[B+3]); PIN(X); SBAR(); }while(0)
  #define VRD(i) do{ vlo[i]=vtr(vp_+(((i)>>2)*4096+((i)&3)*1024)); vhi[i]=vtr(vp_+(((i)>>2)*4096+((i)&3)*1024+512)); }while(0)
  #define KRD(G,t,j) do{ if(G){ kload2(kf,kp0+(tile0+(t)+1)*SLOTB,j); SBAR(); } }while(0)
  #define CK_STEP(C0,C1,P0,P1,t,GL) do{ SBAR(); \
    const lds_cptr vp_=vp0+(tile0+(t)-1)*SLOTB; CK_SETDT(t); \
    C0=MFMA32(CK_KA,__builtin_bit_cast(bf16x8,qa0),f32x16{}); C1=MFMA32(CK_KA,__builtin_bit_cast(bf16x8,qa1),f32x16{}); SBAR(); \
    VRD(0); SBAR(); float sacc=(P0[0]+P0[1]); \
    GAPA(C0=MFMA32(kf[0],qr[0],C0), P0[2],P0[3],P0[4],P0[5],     pw0[0]=PKW(P0,0), pw0[1]=PKW(P0,2), pw0); \
    VRD(4); SBAR(); GAPA(C1=MFMA32(kf[1],qr[0],C1), P0[6],P0[7],P0[8],P0[9],     pw0[2]=PKW(P0,4), pw0[3]=PKW(P0,6), pw0); \
    VRD(1); SBAR(); GAPA(C0=MFMA32(kf[2],qr[1],C0),   P0[10],P0[11],P0[12],P0[13], pw1[0]=PKW(P0,8), pw1[1]=PKW(P0,10), pw1); \
    VRD(5); SBAR(); GAPA(C1=MFMA32(kf[3],qr[1],C1),   P0[14],P0[15],P1[0],P1[1],   pw1[2]=PKW(P0,12),pw1[3]=PKW(P0,14), pw1); \
    VRD(2); SBAR(); GAPA(C0=MFMA32(kf[4],qr[2],C0),   P1[2],P1[3],P1[4],P1[5],     pw2[0]=PKW(P1,0), pw2[1]=PKW(P1,2), pw2); \
    VRD(6); SBAR(); GAPA(C1=MFMA32(kf[5],qr[2],C1),   P1[6],P1[7],P1[8],P1[9],     pw2[2]=PKW(P1,4), pw2[3]=PKW(P1,6), pw2); \
    VRD(3); SBAR(); GAPA(C0=MFMA32(kf[6],qr[3],C0),   P1[10],P1[11],P1[12],P1[13], pw3[0]=PKW(P1,8), pw3[1]=PKW(P1,10), pw3); \
    VRD(7); SBAR(); GAPA(C1=MFMA32(kf[7],qr[3],C1),   P1[14],P1[15],0.f,0.f,       pw3[2]=PKW(P1,12),pw3[3]=PKW(P1,14), pw3); \
    l+=sacc; \
    CK_MASK(C0,C1,t); \
    SBAR(); \
    GAPB(o[0]=MFMA32(PAF(0),VFR(0),o[0]), C0,0); \
    GAPB(o[1]=MFMA32(PAF(0),VFR(4),o[1]), C0,4); \
    KRD(GL,t,0); GAPB(o[0]=MFMA32(PAF(1),VFR(1),o[0]), C0,8); \
    KRD(GL,t,1); GAPB(o[1]=MFMA32(PAF(1),VFR(5),o[1]), C0,12); \
    KRD(GL,t,2); GAPB(o[0]=MFMA32(PAF(2),VFR(2),o[0]), C1,0); \
    KRD(GL,t,3); GAPB(o[1]=MFMA32(PAF(2),VFR(6),o[1]), C1,4); \
    GAPB(o[0]=MFMA32(PAF(3),VFR(3),o[0]), C1,8); \
    GAPB(o[1]=MFMA32(PAF(3),VFR(7),o[1]), C1,12); \
    }while(0)
  #define CK_DRAIN(P0,P1,t) do{ float sacc=P0[0]+P0[1]; _Pragma("unroll") for(int r=2;r<16;++r)sacc+=P0[r]; _Pragma("unroll") for(int r=0;r<16;++r)sacc+=P1[r]; l+=sacc; \
    pw0=(u32x4){PKW(P0,0),PKW(P0,2),PKW(P0,4),PKW(P0,6)};pw1=(u32x4){PKW(P0,8),PKW(P0,10),PKW(P0,12),PKW(P0,14)};pw2=(u32x4){PKW(P1,0),PKW(P1,2),PKW(P1,4),PKW(P1,6)};pw3=(u32x4){PKW(P1,8),PKW(P1,10),PKW(P1,12),PKW(P1,14)}; \
    const lds_cptr vp_=vp0+(tile0+(t))*SLOTB; _Pragma("unroll") for(int i=0;i<8;++i)VRD(i); \
    o[0]=MFMA32(PAF(0),VFR(0),o[0]); o[1]=MFMA32(PAF(0),VFR(4),o[1]); o[0]=MFMA32(PAF(1),VFR(1),o[0]); o[1]=MFMA32(PAF(1),VFR(5),o[1]); \
    o[0]=MFMA32(PAF(2),VFR(2),o[0]); o[1]=MFMA32(PAF(2),VFR(6),o[1]); o[0]=MFMA32(PAF(3),VFR(3),o[0]); o[1]=MFMA32(PAF(3),VFR(7),o[1]); }while(0)
  CK_SETDT(0); kload8(kf,kp0+tile0*SLOTB);
  pA0=MFMA32(CK_KA,__builtin_bit_cast(bf16x8,qa0),f32x16{}); pA1=MFMA32(CK_KA,__builtin_bit_cast(bf16x8,qa1),f32x16{});
  #pragma unroll
  for(int d0=0;d0<4;++d0){ pA0=MFMA32(kf[2*d0],qr[d0],pA0); pA1=MFMA32(kf[2*d0+1],qr[d0],pA1); }
  CK_MASK(pA0,pA1,0);
  if(NT>1){ SBAR(); kload8(kf,kp0+(tile0+1)*SLOTB); }
  #pragma unroll
  for(int r=0;r<16;++r){ pA0[r]=EX(pA0[r]); pA1[r]=EX(pA1[r]); }
  if(NT>1){ CK_STEP(pB0,pB1,pA0,pA1,1,(NT>2)); }
  if(NT>2){ CK_STEP(pA0,pA1,pB0,pB1,2,(NT>3)); }
  if(NT>3){ CK_STEP(pB0,pB1,pA0,pA1,3,false); }
  if(NT==1||NT==3){ CK_DRAIN(pA0,pA1,NT-1); } else { CK_DRAIN(pB0,pB1,NT-1); }
  #undef CK_SETDT
  #undef CK_KA
  #undef CK_MASK
  #undef PKW
  #undef PAF
  #undef VFR
  #undef PIN
  #undef GAPA
  #undef EX
  #undef GAPB
  #undef VRD
  #undef KRD
  #undef CK_STEP
  #undef CK_DRAIN
}
constexpr int GS_QP=0, GS_TJ=4352, GS_PRE=4480, GS_RNG=4736, GS_WSF=4864, GS_DST=6912, GS_STG=8192, GS_C=16384, GS_BYTES=20480;
__device__ __forceinline__ u32x4 stage8(const f32x16*o,const MB_LAS float*wsf,MB_LAS bf16*stg,int k,int lane,int r32,int hi){
  #pragma unroll
  for(int rr=0;rr<4;++rr){ const int r=4*k+rr, lrow=rr+4*hi; const float ri=wsf[32+crow(r,hi)];
    #pragma unroll
    for(int d0=0;d0<2;++d0)stg[lrow*64+d0*32+r32]=(bf16)(cvtpk_s(o[d0][r]*ri,0.f)&0xffffu);}
  asm volatile("s_waitcnt lgkmcnt(0)":::"memory");
  const u32x4 v=*(const MB_LAS u32x4*)(stg+(lane>>3)*64+(lane&7)*8);
  asm volatile("s_waitcnt lgkmcnt(0)":::"memory");
  return v;
}
__device__ __forceinline__ void swa_phase(char*shm,char*scr,const bf16*P,const float*sinks,bf16*Y,int vcu,int G,int uend){
  int tid_=threadIdx.x; asm volatile("":"+v"(tid_));
  const int tid=tid_,lane=tid&63,r32=lane&31,hi=lane>>5; const int wid=__builtin_amdgcn_readfirstlane(tid>>6);
  const int g=wid>>2,qs=32*(wid&3),tl=(qs>=64)?1:0;
  const unsigned lds0=(unsigned)(uintptr_t)shm;
  MB_LAS float*wsf=(MB_LAS float*)(scr+GS_WSF)+wid*64; MB_LAS bf16*stg=(MB_LAS bf16*)(scr+GS_STG)+wid*512;
  const lds_cptr shm3=(lds_cptr)shm; const lds_cptr vp0=shm3+4*SLOTB+((lane>>4)&1)*32+(lane&3)*8+(4*hi+((lane&15)>>2))*64; const lds_cptr kp0=shm3+hi*1024+r32*16;
  const unsigned kdst=lds0+wid*1024, vdst=lds0+4*SLOTB+wid*1024;
  const unsigned hm=hi?0u:0xffffffffu; const float Lh=bfround(LOG2E),Ll=bfround(LOG2E-Lh);
  const int NU=uend;
  #define SWA_DMA(U,BUF) do{ const int n_=(U)&63,kv_=((U)>>6)&1,b_=(U)>>7; const long key0_=128L*(n_-1); const int tf_=(n_==0)?2:0; \
      const bf16*ks_=P+OFF_KC+((size_t)(b_*2+kv_)*SEQ+key0_+lane)*64+wid*8; const bf16*vs_=P+OFF_VC+((size_t)(b_*2+kv_)*SEQ+key0_+16*(wid&3)+(lane>>2))*64+(wid>>2)*32+(lane&3)*8; \
      _Pragma("unroll") for(int t=0;t<4;++t) if(t>=tf_){ glds16(ks_+(long)t*KVBLK*64,(unsigned)__builtin_amdgcn_readfirstlane(kdst+(BUF)*65536+t*SLOTB)); glds16(vs_+(long)t*KVBLK*64,(unsigned)__builtin_amdgcn_readfirstlane(vdst+(BUF)*65536+t*SLOTB)); } }while(0)
  #define SWA_Q(U,QO) do{ const int n_=(U)&63,kv_=((U)>>6)&1,b_=(U)>>7; const bf16*Qw_=P+OFF_QC+((size_t)(b_*4+kv_*2+g)*SEQ+128L*n_+qs+r32)*64+hi*8; _Pragma("unroll") for(int d0=0;d0<4;++d0)QO[d0]=*(const MB_GAS bf16x8*)(Qw_+d0*16); }while(0)
  bf16x8 qr[4],qn[4]; int u=vcu,buf=0;
  if(u<NU){ SWA_DMA(u,0); SWA_Q(u,qr); }
  #pragma unroll 1
  for(;u<NU;u+=G){
    WAIT_BAR(0);
    if(u+G<NU){ SWA_DMA(u+G,buf^1); }
    const int n=u&63,kv=(u>>6)&1,b=u>>7,hq=kv*2+g;
    const float slope=__builtin_amdgcn_exp2f(-(float)(1+hq));
    const unsigned w_A=cvtpk_s(slope*Lh,slope*Ll)&hm, w_32A=cvtpk_s(32.f*slope*Lh,32.f*slope*Ll)&hm;
    const int qq=128+qs+r32;
    const float crow_x=-(slope*LOG2E)*(float)qq, crow_c=bfround(crow_x), crow_d=crow_c-crow_x;
    u32x4 ka,qa0,qa1;
    { const unsigned jw=cvtpk_s((float)r32,(float)r32)&hm; ka[0]=jw; ka[1]=0u; ka[2]=0x3f803f80u&hm; ka[3]=0x3f803f80u&hm;
      const unsigned wm=cvtpk_s(0.f,crow_c)&hm; qa0[0]=w_A;qa0[1]=w_A;qa0[2]=wm;qa0[3]=0u; qa1[0]=w_A;qa1[1]=w_A;qa1[2]=wm;qa1[3]=w_32A; }
    const size_t hrow=(size_t)(b*4+hq)*SEQ+128L*n+qs;
    u32x4 gt[4];
    #pragma unroll
    for(int k=0;k<4;++k) gt[k]=*(const MB_GAS u32x4*)(P+OFF_GC+(hrow+8*k+(lane>>3))*64+(lane&7)*8);
    f32x16 o[2]; o[0]=f32x16{}; o[1]=f32x16{}; float l=0.f;
    const lds_cptr kpb=kp0+buf*65536, vpb=vp0+buf*65536;
    if(n==0){ if(tl) chunk_attn<2,2>(o,l,qr,ka,qa0,qa1,hm,0.f,kpb,vpb,2,r32,hi,qq); else chunk_attn<1,2>(o,l,qr,ka,qa0,qa1,hm,0.f,kpb,vpb,2,r32,hi,qq); }
    else chunk_attn<3,2>(o,l,qr,ka,qa0,qa1,hm,0.f,kpb,vpb,tl,r32,hi,qq);
    if(u+G<NU){ SWA_Q(u+G,qn); }
    { auto rr=__builtin_amdgcn_permlane32_swap(__float_as_uint(l),__float_as_uint(l),false,false); l=__uint_as_float(rr[0])+__uint_as_float(rr[1]); }
    l+=__builtin_amdgcn_exp2f(*(const MB_GAS float*)(sinks+hq)*LOG2E+crow_d);
    if(hi==0)wsf[32+r32]=__builtin_amdgcn_rcpf(l); asm volatile("s_waitcnt lgkmcnt(0)":::"memory");
    const size_t yrow=(size_t)b*SEQ+128L*n+qs;
    #pragma unroll
    for(int k=0;k<4;++k){ const u32x4 v=stage8(o,wsf,stg,k,lane,r32,hi); const u32x4 gg=gt[k]; u32x4 w;
      #pragma unroll
      for(int e=0;e<4;++e) w[e]=cvtpk_s(__uint_as_float(v[e]<<16)*__uint_as_float(gg[e]<<16),__uint_as_float(v[e]&0xffff0000u)*__uint_as_float(gg[e]&0xffff0000u));
      *(MB_GAS u32x4*)(Y+(yrow+8*k+(lane>>3))*YPITCH+512+hq*D+(lane&7)*8)=w; }
    #pragma unroll
    for(int d0=0;d0<4;++d0)qr[d0]=qn[d0];
    buf^=1;
  }
  #undef SWA_DMA
  #undef SWA_Q
  asm volatile("s_waitcnt vmcnt(0) lgkmcnt(0)\n\ts_barrier":::"memory");
}
constexpr int SP_LDS_C=65536, SP_LDS_WSF=65536+12288, SP_LDS_DST=SP_LDS_WSF+NW*256, SP_LDS_STG=SP_LDS_DST+NW*128, SP_LDS_BYTES=SP_LDS_STG+NW*4096;
typedef __attribute__((address_space(3))) unsigned lds_u32;
__device__ __forceinline__ void select_phase(char*scr,const bf16*P,const float*kmean,unsigned*cnt,unsigned short*lst,int vcu,int G,int uend){
  int tid_=threadIdx.x; asm volatile("":"+v"(tid_));
  const int tid=tid_,lane=tid&63,r32=lane&31,hi=lane>>5; const int wid=__builtin_amdgcn_readfirstlane(tid>>6);
  lds_u32*ldscnt=(lds_u32*)(scr+GS_C);
  const int qrel=wid*QBLK+r32;
  #pragma unroll 1
  for(int u=vcu;u<uend;u+=G){
    const int bh=u>>5,qb=u&31;
    if(tid<32)ldscnt[tid]=0u;
    bf16x8 qr[4];
    #pragma unroll
    for(int d0=0;d0<4;++d0)qr[d0]=*(const MB_GAS bf16x8*)(&P[OFF_QA+((size_t)bh*SEQ+qb*QB+qrel)*64+d0*16+hi*8]);
    f32x16 bsc=f32x16{};
    const float*kmr=kmean+(size_t)bh*32*64+r32*64+hi*8;
    #pragma unroll
    for(int d0=0;d0<4;++d0){ const f32x4 a=*(const MB_GAS f32x4*)(kmr+d0*16), c=*(const MB_GAS f32x4*)(kmr+d0*16+4);
      const float x[8]={a[0],a[1],a[2],a[3],c[0],c[1],c[2],c[3]}; u32x4 hw,lw;
      #pragma unroll
      for(int i=0;i<4;++i){ const unsigned ph=cvtpk_s(x[2*i],x[2*i+1]); const float h0=__uint_as_float(ph<<16),h1=__uint_as_float(ph&0xffff0000u); hw[i]=ph; lw[i]=cvtpk_s(x[2*i]-h0,x[2*i+1]-h1); }
      bsc=MFMA32(__builtin_bit_cast(bf16x8,hw),qr[d0],bsc); bsc=MFMA32(__builtin_bit_cast(bf16x8,lw),qr[d0],bsc); }
    #pragma unroll
    for(int r=0;r<16;++r) if(crow(r,hi)>=qb) bsc[r]=-INFINITY;
    int wn[3]; bool wok[3];
    #pragma unroll
    for(int rd=0;rd<3;++rd){
      float bv=bsc[0]; int bi=crow(0,hi);
      #pragma unroll
      for(int r=1;r<16;++r){ if(bsc[r]>bv){bv=bsc[r];bi=crow(r,hi);} }
      auto sv=__builtin_amdgcn_permlane32_swap(__float_as_uint(bv),__float_as_uint(bv),false,false);
      auto si=__builtin_amdgcn_permlane32_swap((unsigned)bi,(unsigned)bi,false,false);
      const float v0=__uint_as_float(sv[0]),v1=__uint_as_float(sv[1]); const int i0=(int)si[0],i1=(int)si[1];
      const bool first=(v0>v1)||(v0==v1&&i0<i1); const float wv=first?v0:v1; wn[rd]=first?i0:i1; wok[rd]=wv>-INFINITY;
      #pragma unroll
      for(int r=0;r<16;++r) if(crow(r,hi)==wn[rd]) bsc[r]=-INFINITY;
    }
    asm volatile("s_waitcnt lgkmcnt(0)\n\ts_barrier":::"memory");
    #pragma unroll
    for(int rd=0;rd<3;++rd) if(wok[rd]&&hi==0){ const unsigned pos=__hip_atomic_fetch_add(ldscnt+wn[rd],1u,__ATOMIC_RELAXED,__HIP_MEMORY_SCOPE_WORKGROUP);
        *(MB_GAS unsigned short*)(lst+(((size_t)bh*32+wn[rd])*32+qb)*256+pos)=(unsigned short)((rd<<8)|qrel); }
    asm volatile("s_waitcnt lgkmcnt(0)\n\ts_barrier":::"memory");
    if(tid<32)*(MB_GAS unsigned*)(cnt+((size_t)bh*32+tid)*32+qb)=ldscnt[tid];
  }
  asm volatile("s_waitcnt lgkmcnt(0)\n\ts_barrier":::"memory");
}
__device__ __forceinline__ void own_merge_phase(char*shm,char*scr,const bf16*P,const bf16*partO,const float*partL,bf16*Y,int vcu,int G,int uend){
  int tid_=threadIdx.x; asm volatile("":"+v"(tid_));
  const int tid=tid_,lane=tid&63,r32=lane&31,hi=lane>>5; const int wid=__builtin_amdgcn_readfirstlane(tid>>6);
  const unsigned lds0=(unsigned)(uintptr_t)shm;
  MB_LAS float*wsf=(MB_LAS float*)(scr+GS_WSF)+wid*64; MB_LAS bf16*stg=(MB_LAS bf16*)(scr+GS_STG)+wid*512;
  const lds_cptr shm3=(lds_cptr)shm; const lds_cptr vp0=shm3+4*SLOTB+((lane>>4)&1)*32+(lane&3)*8+(4*hi+((lane&15)>>2))*64; const lds_cptr kp0=shm3+hi*1024+r32*16;
  const unsigned kdst=lds0+wid*1024, vdst=lds0+4*SLOTB+wid*1024;
  const unsigned hm=hi?0u:0xffffffffu; const float Lh=bfround(LOG2E),Ll=bfround(LOG2E-Lh);
  const int qrel=wid*QBLK+r32, NU=uend;
  #define OWN_DMA(U,BUF) do{ const int bh_=(U)>>5,qb_=(U)&31; const bf16*ks_=P+OFF_KA+((size_t)bh_*SEQ+qb_*QB+lane)*64+wid*8; const bf16*vs_=P+OFF_VA+((size_t)bh_*SEQ+qb_*QB+16*(wid&3)+(lane>>2))*64+(wid>>2)*32+(lane&3)*8; \
      _Pragma("unroll") for(int t=0;t<4;++t){ glds16(ks_+(long)t*KVBLK*64,(unsigned)__builtin_amdgcn_readfirstlane(kdst+(BUF)*65536+t*SLOTB)); glds16(vs_+(long)t*KVBLK*64,(unsigned)__builtin_amdgcn_readfirstlane(vdst+(BUF)*65536+t*SLOTB)); } }while(0)
  #define OWN_Q(U,QO) do{ const int bh_=(U)>>5,qb_=(U)&31; const bf16*Qw_=P+OFF_QA+((size_t)bh_*SEQ+qb_*QB+qrel)*64+hi*8; _Pragma("unroll") for(int d0=0;d0<4;++d0)QO[d0]=*(const MB_GAS bf16x8*)(Qw_+d0*16); }while(0)
  bf16x8 qr[4],qn[4]; int u=vcu,buf=0;
  if(u<NU){ OWN_DMA(u,0); OWN_Q(u,qr); }
  #pragma unroll 1
  for(;u<NU;u+=G){
    WAIT_BAR(0);
    if(u+G<NU){ OWN_DMA(u+G,buf^1); }
    const int bh=u>>5,qb=u&31,h=bh&3,b=bh>>2,nsel=qb<3?qb:3;
    const float slope=__builtin_amdgcn_exp2f(-(float)(5+h));
    const unsigned w_A=cvtpk_s(slope*Lh,slope*Ll)&hm, w_32A=cvtpk_s(32.f*slope*Lh,32.f*slope*Ll)&hm;
    const float crow_x=-(slope*LOG2E)*(float)qrel, crow_c=bfround(crow_x), crow_d=crow_c-crow_x;
    u32x4 ka,qa0,qa1;
    { const unsigned jw=cvtpk_s((float)r32,(float)r32)&hm; ka[0]=jw; ka[1]=0u; ka[2]=0x3f803f80u&hm; ka[3]=0x3f803f80u&hm;
      const unsigned wm=cvtpk_s(0.f,crow_c)&hm; qa0[0]=w_A;qa0[1]=w_A;qa0[2]=wm;qa0[3]=0u; qa1[0]=w_A;qa1[1]=w_A;qa1[2]=wm;qa1[3]=w_32A; }
    f32x16 o[2]; o[0]=f32x16{}; o[1]=f32x16{}; float l=0.f;
    const lds_cptr kpb=kp0+buf*65536, vpb=vp0+buf*65536; const int tlast=wid>>1, qd=qrel-64*tlast;
    if(tlast==0) chunk_attn<1,1>(o,l,qr,ka,qa0,qa1,hm,0.f,kpb,vpb,0,r32,hi,qd); else if(tlast==1) chunk_attn<2,1>(o,l,qr,ka,qa0,qa1,hm,0.f,kpb,vpb,0,r32,hi,qd);
    else if(tlast==2) chunk_attn<3,1>(o,l,qr,ka,qa0,qa1,hm,0.f,kpb,vpb,0,r32,hi,qd); else chunk_attn<4,1>(o,l,qr,ka,qa0,qa1,hm,0.f,kpb,vpb,0,r32,hi,qd);
    { auto rr=__builtin_amdgcn_permlane32_swap(__float_as_uint(l),__float_as_uint(l),false,false); l=__uint_as_float(rr[0])+__uint_as_float(rr[1]); }
    if(u+G<NU){ OWN_Q(u+G,qn); }
    const float sh=__builtin_amdgcn_exp2f(-crow_d);
    if(hi==0){ wsf[r32]=l*sh; wsf[32+r32]=sh; } asm volatile("s_waitcnt lgkmcnt(0)":::"memory");
    const size_t q0row=(size_t)bh*SEQ+qb*QB+wid*QBLK;
    f32x4 lv4[4]; u32x4 pp0[4],pp1[4],pp2[4],gg4[4];
    #pragma unroll
    for(int k=0;k<4;++k){ const int row=8*k+(lane>>3),ch=lane&7; const bf16*po=partO+(q0row+row)*256+ch*8;
      lv4[k]=*(const MB_GAS f32x4*)(partL+(q0row+row)*4);
      pp0[k]=(u32x4){0u,0u,0u,0u}; pp1[k]=pp0[k]; pp2[k]=pp0[k];
      if(nsel>0)pp0[k]=*(const MB_GAS u32x4*)(po); if(nsel>1)pp1[k]=*(const MB_GAS u32x4*)(po+64); if(nsel>2)pp2[k]=*(const MB_GAS u32x4*)(po+128);
      gg4[k]=*(const MB_GAS u32x4*)(P+OFF_GA+(q0row+row)*64+ch*8); }
    #pragma unroll
    for(int k=0;k<4;++k){ const int row=8*k+(lane>>3),ch=lane&7;
      const f32x4 lv=lv4[k]; const u32x4 p0=pp0[k],p1=pp1[k],p2=pp2[k],gg=gg4[k];
      const u32x4 v=stage8(o,wsf,stg,k,lane,r32,hi);
      const float l0=nsel>0?lv[0]:0.f,l1=nsel>1?lv[1]:0.f,l2=nsel>2?lv[2]:0.f; const float iw=__builtin_amdgcn_rcpf(wsf[row]+l0+l1+l2); u32x4 w;
      #pragma unroll
      for(int e=0;e<4;++e){ const float a0=__uint_as_float(v[e]<<16)+l0*__uint_as_float(p0[e]<<16)+l1*__uint_as_float(p1[e]<<16)+l2*__uint_as_float(p2[e]<<16);
        const float a1=__uint_as_float(v[e]&0xffff0000u)+l0*__uint_as_float(p0[e]&0xffff0000u)+l1*__uint_as_float(p1[e]&0xffff0000u)+l2*__uint_as_float(p2[e]&0xffff0000u);
        w[e]=cvtpk_s(a0*iw*__uint_as_float(gg[e]<<16),a1*iw*__uint_as_float(gg[e]&0xffff0000u)); }
      *(MB_GAS u32x4*)(Y+((size_t)b*SEQ+qb*QB+wid*QBLK+row)*YPITCH+h*D+ch*8)=w; }
    #pragma unroll
    for(int d0=0;d0<4;++d0)qr[d0]=qn[d0];
    buf^=1;
  }
  #undef OWN_DMA
  #undef OWN_Q
  asm volatile("s_waitcnt vmcnt(0) lgkmcnt(0)\n\ts_barrier":::"memory");
}
__device__ __forceinline__ void sp_store8(const f32x16*o,float linv_src,bf16*base,const MB_LAS int*dstl,MB_LAS float*wsf,MB_LAS bf16*stg,int lane,int r32,int hi){
  if(hi==0)wsf[32+r32]=linv_src; asm volatile("s_waitcnt lgkmcnt(0)":::"memory");
  #pragma unroll
  for(int k=0;k<4;++k){
    #pragma unroll
    for(int rr=0;rr<4;++rr){ const int r=4*k+rr, lrow=rr+4*hi; const float ri=wsf[32+crow(r,hi)];
      #pragma unroll
      for(int d0=0;d0<2;++d0)stg[lrow*64+d0*32+r32]=(bf16)(cvtpk_s(o[d0][r]*ri,0.f)&0xffffu);}
    asm volatile("s_waitcnt lgkmcnt(0)":::"memory");
    { const int lrow=lane>>3,ch=lane&7; const long d=dstl[8*k+lrow]; const u32x4 v=*(const MB_LAS u32x4*)(stg+lrow*64+ch*8); if(d>=0) *(MB_GAS u32x4*)(base+d+ch*8)=v; }
    asm volatile("s_waitcnt lgkmcnt(0)":::"memory");
  }
}
__device__ __forceinline__ void gather_phase(char*shm,char*scr,const bf16*P,const unsigned*cnt,const unsigned short*lst,bf16*partO,float*partL,int vcu){
  int tid_=threadIdx.x; asm volatile("":"+v"(tid_));
  const int tid=tid_,lane=tid&63,r32=lane&31,hi=lane>>5; const int wid=__builtin_amdgcn_readfirstlane(tid>>6);
  const int bh=vcu>>3,sv=vcu&7,b=bh>>2,h=bh&3; const long rowbase=(long)b*SEQ;
  const unsigned lds0=(unsigned)(uintptr_t)shm;
  volatile lds_u32*C=(volatile lds_u32*)(scr+GS_C); volatile lds_u32*Tj=(volatile lds_u32*)(scr+GS_TJ); volatile lds_u32*pre=(volatile lds_u32*)(scr+GS_PRE); volatile lds_u32*QP=(volatile lds_u32*)(scr+GS_QP); volatile lds_u32*RNG=(volatile lds_u32*)(scr+GS_RNG);
  MB_LAS float*wsf=(MB_LAS float*)(scr+GS_WSF)+wid*64; MB_LAS int*dstl=(MB_LAS int*)(scr+GS_DST)+wid*32; MB_LAS bf16*stg=(MB_LAS bf16*)(scr+GS_STG)+wid*512;
  if(tid<32){ unsigned cj[32];
    #pragma unroll
    for(int q4=0;q4<8;++q4){ const u32x4 t4=*(const MB_GAS u32x4*)(cnt+(size_t)bh*1024+tid*32+4*q4); cj[4*q4]=t4[0]; cj[4*q4+1]=t4[1]; cj[4*q4+2]=t4[2]; cj[4*q4+3]=t4[3]; }
    unsigned run=0u;
    #pragma unroll
    for(int q=0;q<32;++q){ QP[tid*33+q]=run; run+=(q>tid)?cj[q]:0u; }
    QP[tid*33+32]=run; Tj[tid]=run;
    const unsigned n=(run+255u)>>8, wgt=n?2u*n+1u:0u; unsigned pn=n, pw=wgt;
    #pragma unroll
    for(int o=1;o<32;o<<=1){ const unsigned a=__shfl_up(pn,o,32), bq=__shfl_up(pw,o,32); if(tid>=o){ pn+=a; pw+=bq; } }
    const unsigned ntot=__shfl(pn,31,32), wt=__shfl(pw,31,32);
    pre[tid]=pn-n; if(tid==31)pre[32]=ntot;
    const unsigned p2=pw-wgt;
    #pragma unroll
    for(int k=0;k<2;++k){ const unsigned target=wt*(unsigned)(sv+k)/8u; unsigned cc=0u; if(n&&target>p2+1u){ cc=(target-p2)>>1; if(cc>n)cc=n; }
      #pragma unroll
      for(int o=16;o>=1;o>>=1) cc+=__shfl_xor(cc,o,32);
      if(tid==0)RNG[k]=cc; } }
  asm volatile("s_waitcnt vmcnt(0) lgkmcnt(0)\n\ts_barrier":::"memory");
  const int i0=(int)RNG[0], i1=(int)RNG[1];
  const unsigned hm=hi?0u:0xffffffffu;
  const float slope=__builtin_amdgcn_exp2f(-(float)(5+h)),sl2=slope*LOG2E;
  const float Lh=bfround(LOG2E),Ll=bfround(LOG2E-Lh);
  const unsigned w_A=cvtpk_s(slope*Lh,slope*Ll)&hm, w_32A=cvtpk_s(32.f*slope*Lh,32.f*slope*Ll)&hm;
  u32x4 ka,qa0,qa1;
  { const unsigned jw=cvtpk_s((float)r32,(float)r32)&hm; ka[0]=jw; ka[1]=0u; ka[2]=0x3f803f80u&hm; ka[3]=0x3f803f80u&hm;
    qa0[0]=w_A;qa0[1]=w_A;qa0[2]=0u;qa0[3]=0u; qa1[0]=w_A;qa1[1]=w_A;qa1[2]=0u;qa1[3]=w_32A; }
  const lds_cptr shm3=(lds_cptr)shm; const lds_cptr vp0=shm3+4*SLOTB+((lane>>4)&1)*32+(lane&3)*8+(4*hi+((lane&15)>>2))*64; const lds_cptr kp0=shm3+hi*1024+r32*16;
  const unsigned kdst=lds0+wid*1024, vdst=lds0+4*SLOTB+wid*1024;
  #define BLK_DMA(J,BUF) do{ const bf16*ks_=P+OFF_KA+((size_t)bh*SEQ+256L*(J)+lane)*64+wid*8; const bf16*vs_=P+OFF_VA+((size_t)bh*SEQ+256L*(J)+16*(wid&3)+(lane>>2))*64+(wid>>2)*32+(lane&3)*8; \
      _Pragma("unroll") for(int t=0;t<4;++t){ glds16(ks_+(long)t*KVBLK*64,(unsigned)__builtin_amdgcn_readfirstlane(kdst+(BUF)*65536+t*SLOTB)); glds16(vs_+(long)t*KVBLK*64,(unsigned)__builtin_amdgcn_readfirstlane(vdst+(BUF)*65536+t*SLOTB)); } }while(0)
  int jn=0;
  #define LOOKUP(IT,JO,EO,VO) do{ const int it_=(IT); JO=-1; EO=0u; VO=false; if(it_<i1){ while((int)pre[jn+1]<=it_)++jn; JO=jn; const int c_=it_-(int)pre[jn]; const int T_=(int)Tj[jn]; \
      const int g_=256*c_+wid*QBLK+r32; VO=g_<T_; const int gg_=VO?g_:T_-1; int qb_=0; _Pragma("unroll") for(int st=16;st>=1;st>>=1) if((int)QP[jn*33+qb_+st]<=gg_) qb_+=st; \
      const int idx_=gg_-(int)QP[jn*33+qb_]; EO=(unsigned)qb_<<16|(unsigned)*(const MB_GAS unsigned short*)(lst+(((size_t)bh*32+jn)*32+qb_)*256+idx_); } }while(0)
  #define QLOAD(EI,QO,TQO) do{ TQO=256*(int)((EI)>>16)+(int)((EI)&255u); const bf16*Qp_=P+OFF_QA+((size_t)bh*SEQ+TQO)*64+hi*8; _Pragma("unroll") for(int d0=0;d0<4;++d0)QO[d0]=*(const MB_GAS bf16x8*)(Qp_+d0*16); }while(0)
  int j0_,j1_,j2_; unsigned e0_,e1_,e2_; bool v0_,v1_,v2_; bf16x8 qr[4],qn[4]; int tq=0,tqn=0;
  LOOKUP(i0,j0_,e0_,v0_); LOOKUP(i0+1,j1_,e1_,v1_);
  if(i0<i1){ QLOAD(e0_,qr,tq); BLK_DMA(j0_,0); }
  int curj=-1,buf=1,pfj=(i0<i1)?j0_:-1;
  #pragma unroll 1
  for(int it=i0;it<i1;++it){
    const int j=j0_; const bool valid=v0_; const int slot=(int)((e0_>>8)&255u);
    if(j!=curj){ buf^=1; WAIT_BAR(0); curj=j; }
    LOOKUP(it+2,j2_,e2_,v2_);
    if(it+1<i1) QLOAD(e1_,qn,tqn);
    if(j1_>=0&&j1_!=j&&pfj!=j1_){
      asm volatile("s_waitcnt lgkmcnt(0)\n\ts_barrier":::"memory");
      BLK_DMA(j1_,buf^1); pfj=j1_; }
    const lds_cptr kpb=kp0+buf*65536, vpb=vp0+buf*65536;
    f32x16 o[2]; o[0]=f32x16{}; o[1]=f32x16{}; float l=0.f;
    chunk_attn<4,0>(o,l,qr,ka,qa0,qa1,hm,-255.f,kpb,vpb,0,r32,hi,0);
    { auto rr=__builtin_amdgcn_permlane32_swap(__float_as_uint(l),__float_as_uint(l),false,false); l=__uint_as_float(rr[0])+__uint_as_float(rr[1]); }
    const size_t prow=((size_t)bh*SEQ+tq)*4+slot;
    if(hi==0){ dstl[r32]=valid?(int)(prow*64):-1; if(valid) *(MB_GAS float*)(partL+prow)=l*__builtin_amdgcn_exp2f(sl2*(float)(256*j+255-tq)); }
    sp_store8(o,__builtin_amdgcn_rcpf(l),partO,dstl,wsf,stg,lane,r32,hi);
    j0_=j1_;e0_=e1_;v0_=v1_; j1_=j2_;e1_=e2_;v1_=v2_; tq=tqn;
    #pragma unroll
    for(int d0=0;d0<4;++d0)qr[d0]=qn[d0];
  }
  #undef LOOKUP
  #undef QLOAD
  #undef BLK_DMA
  asm volatile("s_waitcnt vmcnt(0) lgkmcnt(0)\n\ts_barrier":::"memory");
}
#undef SBAR
#undef WAIT_BAR
#undef MFMA32
#undef MX3
}
constexpr int NWAVES = 8;
#ifndef IN_ONE_CALL
#define IN_ONE_CALL 0
#endif
#ifndef STAGGER_IN
#define STAGGER_IN 0
#endif
#ifndef STAGGER_OUT
#define STAGGER_OUT 0
#endif
#ifndef MK_N_LAUNCHES
#define MK_N_LAUNCHES 1
#endif
constexpr int N_LAUNCHES = MK_N_LAUNCHES;
constexpr int N_PHASES = 11;
static_assert(WS_WIN + 2 * (size_t)NPROJ * DM * 2 <= WS_WOUT && WS_WOUT + 2 * (size_t)DM * DM * 2 <= WS_XB && WS_XB + (size_t)M * DM * 2 <= WS_Y && WS_Y + (size_t)M * DM * 2 <= WS_PROJ && WS_PROJ + (size_t)M * NPROJ * 2 <= WS_END, "d_ws map");
constexpr int CW_TMO = 0, CW_BAR = 4096, CW_GRP = 8192;
static_assert(CW_BAR + XCD_BAR_WORDS <= CW_GRP && (CW_GRP + 1536) * 4 <= 64 * 1024 && (CW_BAR + XCD_BAR_WORDS) * 4 <= (int)WS_KMEAN && WS_KMEAN + 2 * 65536 * 4 <= WS_SSQ2 && WS_SSQ2 + (size_t)M * 4 <= CTL_ZERO_BYTES, "ctl map");
constexpr int RING_OFF = 0, RING_BYTES = 131072;
constexpr int LDSCTL_OFF = RING_BYTES, MISC_OFF = LDSCTL_OFF + 320, AUX_OFF = RING_BYTES + 4096;
constexpr int SCR_OFF = AUX_OFF + 4096;
constexpr int LDS_BYTES = 163840;
static_assert(SCR_OFF + moba_body::GS_BYTES <= LDS_BYTES, "LDS map");

struct Frame {
    LAS unsigned char* lds; volatile LAS unsigned* MISC; gu32* ctl;
    int tid, lane, wave, vcu, G;
    const float *x, *norm_g, *w_in, *w_out, *a_qn, *a_kn, *pool_w, *pool_scale, *c_qn, *c_kn, *c_sinks, *conv_w;
    float* out;
    bf16 *Win_t, *Wout_t, *XB, *Y, *PROJ; float *kmean, *ssq1, *ssq2;
    unsigned* cnt; unsigned short* lst; bf16* partO; float* partL; float *Hu, *Hg;
    __device__ __forceinline__ void refresh() { int t = threadIdx.x; asm volatile("" : "+v"(t)); tid = t; lane = t & 63; wave = __builtin_amdgcn_readfirstlane(t >> 6); int v = vcu; asm volatile("" : "+s"(v)); vcu = v; }
};
__device__ __forceinline__ float bf2f(bf16 b) { return __uint_as_float((unsigned)b << 16); }
__device__ __forceinline__ float wave_sum(float v) {
#pragma unroll
    for (int o = 1; o < 64; o <<= 1) v += __shfl_xor(v, o);
    return v;
}
__device__ __forceinline__ float wave_max(float v) {
#pragma unroll
    for (int o = 1; o < 64; o <<= 1) v = fmaxf(v, __shfl_xor(v, o));
    return v;
}
__device__ __forceinline__ float rdl(float v, int l) { return __uint_as_float((unsigned)__builtin_amdgcn_readlane((int)__float_as_uint(v), l)); }
__device__ __forceinline__ void p0_store_item(LAS float* scr, bf16* WT, int n0, bool mapped, int k0, int lane) {
    LDS_WAIT(); asm volatile("" ::: "memory");
    const int c = lane & 7;
#pragma unroll
    for (int j = 0; j < 4; ++j) { const int n = (lane >> 3) + 8 * j; const LAS float* s = scr + (8 * c) * 33 + n;
        v4u o; o.x = pk2(s[0 * 33], s[1 * 33]); o.y = pk2(s[2 * 33], s[3 * 33]); o.z = pk2(s[4 * 33], s[5 * 33]); o.w = pk2(s[6 * 33], s[7 * 33]);
        const int prow = mapped ? phys_row(n0 + n) : n0 + n;
        *(GAS v4u*)(WT + (size_t)prow * 1024 + k0 + 8 * c) = o; }
    LDS_WAIT(); asm volatile("" ::: "memory");
}
__device__ __forceinline__ void p0_prologue(Frame& F) {
    F.refresh();
    LAS float* scr = (LAS float*)(F.lds + RING_OFF + F.wave * 16384);
    const int gw = F.vcu * NWAVES + F.wave, NGW = F.G * NWAVES, lane = F.lane;
    constexpr int I_IN = 16 * 104, I_OUT = 16 * 32, I_L = I_IN + I_OUT;
    for (int it = gw; it < NLAYER * I_L; it += NGW) {
        const int l = it / I_L; int r = it % I_L;
        if (r < I_IN) {
            const int kb = r / 104, nb = r % 104, k0 = 64 * kb, n0 = 32 * nb;
            const float* W = F.w_in + (size_t)l * 1024 * NPROJ; const float* gn = F.norm_g + l * 1024;
            if (n0 >= C_BU && n0 < C_BG) {
                const int g = (n0 - C_BU) >> 6, np0 = (n0 - C_BU) & 63; const float* pw = F.pool_w + ((size_t)l * 4 + g) * 64 * 64 + np0; const float* ps = F.pool_scale + l * 256 + (n0 - C_BU);
                const GAS f32x4* wrow = (const GAS f32x4*)(W + (size_t)(k0 + lane) * NPROJ + C_BU + 64 * g); float wv[64], accp[32];
#pragma unroll
                for (int q = 0; q < 16; ++q) { const f32x4 t4 = wrow[q]; wv[4 * q] = t4.x; wv[4 * q + 1] = t4.y; wv[4 * q + 2] = t4.z; wv[4 * q + 3] = t4.w; }
#pragma unroll
                for (int n = 0; n < 32; ++n) accp[n] = 0.f;
#pragma unroll
                for (int cc = 0; cc < 64; ++cc) {
#pragma unroll
                    for (int n = 0; n < 32; ++n) accp[n] += wv[cc] * pw[cc * 64 + n]; }
                const float gk = gn[k0 + lane];
#pragma unroll
                for (int n = 0; n < 32; ++n) scr[lane * 33 + n] = accp[n] * ps[n] * gk;
            } else {
#pragma unroll 8
                for (int i = 0; i < 32; ++i) { const int kk = 2 * i + (lane >> 5); scr[kk * 33 + (lane & 31)] = W[(size_t)(k0 + kk) * NPROJ + n0 + (lane & 31)] * gn[k0 + kk]; }
            }
            p0_store_item(scr, F.Win_t + (size_t)l * NPROJ * 1024, n0, true, k0, lane);
        } else {
            r -= I_IN; const int kb = r / 32, nb = r % 32, k0 = 64 * kb, n0 = 32 * nb; const float* W = F.w_out + (size_t)l * 1024 * 1024;
#pragma unroll 8
            for (int i = 0; i < 32; ++i) { const int kk = 2 * i + (lane >> 5); scr[kk * 33 + (lane & 31)] = W[(size_t)(k0 + kk) * 1024 + n0 + (lane & 31)]; }
            p0_store_item(scr, F.Wout_t + (size_t)l * 1024 * 1024, n0, false, k0, lane);
        }
    }
    { GAS f32x4* z0 = (GAS f32x4*)F.kmean; GAS f32x4* z1 = (GAS f32x4*)F.ssq2; const int gtid = F.vcu * (NWAVES * 64) + F.tid, ngt = F.G * NWAVES * 64;
      for (int i = gtid; i < 2 * 65536 / 4; i += ngt) z0[i] = (f32x4){0.f, 0.f, 0.f, 0.f};
      for (int i = gtid; i < M / 4; i += ngt) z1[i] = (f32x4){0.f, 0.f, 0.f, 0.f}; }
    for (int m0 = 4 * gw; m0 < M; m0 += 4 * NGW) {
        f32x4 v[4][4]; float s[4];
#pragma unroll
        for (int q = 0; q < 4; ++q) { const GAS f32x4* xr = (const GAS f32x4*)(F.x + (size_t)(m0 + q) * DM) + lane;
#pragma unroll
            for (int j = 0; j < 4; ++j) v[q][j] = __builtin_nontemporal_load(xr + 64 * j); }
#pragma unroll
        for (int q = 0; q < 4; ++q) { s[q] = 0.f;
#pragma unroll
            for (int j = 0; j < 4; ++j) s[q] += (v[q][j].x * v[q][j].x + v[q][j].y * v[q][j].y) + (v[q][j].z * v[q][j].z + v[q][j].w * v[q][j].w); }
#pragma unroll
        for (int o = 1; o < 64; o <<= 1) {
#pragma unroll
            for (int q = 0; q < 4; ++q) s[q] += __shfl_xor(s[q], o); }
        if (lane < 4) F.ssq1[m0 + lane] = lane == 0 ? s[0] : lane == 1 ? s[1] : lane == 2 ? s[2] : s[3];
#pragma unroll
        for (int q = 0; q < 4; ++q) { GAS unsigned long long* o8 = (GAS unsigned long long*)(F.XB + (size_t)(m0 + q) * DM) + lane;
#pragma unroll
            for (int j = 0; j < 4; ++j) o8[64 * j] = (unsigned long long)pk2(v[q][j].x, v[q][j].y) | ((unsigned long long)pk2(v[q][j].z, v[q][j].w) << 32); }
    }
}
__device__ __forceinline__ void convfix_phase(Frame& F, int layer) {
    F.refresh();
    const float* cw = F.conv_w + (size_t)layer * 768;
    { const int c = F.tid & 255, r = (F.tid >> 8) & 1, pm = (F.vcu >> 5) * 32 + (F.vcu & 31);
      if ((pm & 31) != 0) {
        const float u1 = F.Hu[((size_t)(pm - 1) * 2 + 1) * 256 + c], u2 = F.Hu[((size_t)(pm - 1) * 2 + 0) * 256 + c], g = F.Hg[((size_t)pm * 2 + r) * 256 + c];
        const float fix = g * (r == 0 ? cw[c] * u2 + cw[256 + c] * u1 : cw[c] * u1);
        bf16* y = F.Y + (size_t)(pm * 256 + r) * DM + 768 + c; *y = (bf16)f2bf(bf2f(*y) + fix); } }
}
__device__ __forceinline__ void poolfix_phase(Frame& F, int layer) {
    F.refresh();
    const float* Hpu = (const float*)((const char*)F.PROJ - WS_PROJ + WS_PHALO); const float* Hpg = Hpu + 256 * 16 * 256;
    if (F.tid < 256) { const int c = F.tid, pm = (F.vcu >> 5) * 32 + (F.vcu & 31);
        if ((pm & 31) == 0) return;
        const int w = 2 << (c >> 6); float up[15], gq[15], yv[15];
#pragma unroll
        for (int d = 1; d <= 15; ++d) up[d - 1] = d < w ? Hpu[((size_t)(pm - 1) * 16 + 16 - d) * 256 + c] : 0.f;
#pragma unroll
        for (int r = 0; r < 15; ++r) { const bool on = r < w - 1; gq[r] = on ? Hpg[((size_t)pm * 16 + r) * 256 + c] : 0.f; yv[r] = on ? bf2f(F.Y[(size_t)(pm * 256 + r) * DM + 256 + c]) : 0.f; }
        float s = 0.f;
#pragma unroll
        for (int d = 0; d < 15; ++d) s += up[d];
        const float iw = 1.0f / (float)w;
#pragma unroll
        for (int r = 0; r < 15; ++r) { if (r < w - 1) { F.Y[(size_t)(pm * 256 + r) * DM + 256 + c] = (bf16)f2bf(yv[r] + s * iw * gq[r]); s -= up[w - 2 - r]; } }
    }
}
struct Args { const float* in[12]; float* out; unsigned char* ws; int ph_lo, ph_hi, li, pad; };
__global__ void __launch_bounds__(NWAVES * 64, 2) hybrid_fwd(Args args) {
    extern __shared__ __attribute__((aligned(16))) unsigned char lds[];
    Frame F;
    F.lds = (LAS unsigned char*)lds; F.MISC = (volatile LAS unsigned*)(F.lds + MISC_OFF);
    F.tid = threadIdx.x; F.lane = F.tid & 63; F.wave = __builtin_amdgcn_readfirstlane(F.tid >> 6);
    F.G = gridDim.x; { const int bx = blockIdx.x; F.vcu = (F.G % 8 == 0) ? (bx % 8) * (F.G / 8) + bx / 8 : bx; }
    unsigned char* ws = args.ws;
    F.ctl = (gu32*)(ws + WS_CTL);
    F.x = args.in[0]; F.norm_g = args.in[1]; F.w_in = args.in[2]; F.w_out = args.in[3]; F.a_qn = args.in[4]; F.a_kn = args.in[5]; F.pool_w = args.in[6]; F.pool_scale = args.in[7];
    F.c_qn = args.in[8]; F.c_kn = args.in[9]; F.c_sinks = args.in[10]; F.conv_w = args.in[11]; F.out = args.out;
    F.Win_t = (bf16*)(ws + WS_WIN); F.Wout_t = (bf16*)(ws + WS_WOUT); F.XB = (bf16*)(ws + WS_XB); F.Y = (bf16*)(ws + WS_Y); F.PROJ = (bf16*)(ws + WS_PROJ);
    F.kmean = (float*)(ws + WS_KMEAN); F.ssq1 = (float*)(ws + WS_SSQ1); F.ssq2 = (float*)(ws + WS_SSQ2);
    F.cnt = (unsigned*)(ws + WS_CNT); F.lst = (unsigned short*)(ws + WS_LST); F.partO = (bf16*)(ws + WS_PARTO); F.partL = (float*)(ws + WS_PARTL); F.Hu = (float*)(ws + WS_HALO); F.Hg = F.Hu + 256 * 2 * 256;
    for (int u = F.tid; u < (AUX_OFF - LDSCTL_OFF) / 4; u += NWAVES * 64) ((LAS unsigned*)(F.lds + LDSCTL_OFF))[u] = 0u;
    __syncthreads();
    XcdBarrier bar; bar.bar = (unsigned*)(F.ctl + CW_BAR); bar.x = 0; bar.st = nullptr;
    if (N_LAUNCHES == 1) bar = xcd_barrier_post((unsigned*)(F.ctl + CW_BAR), F.MISC + 8);
#define GU0 ((F.vcu >> 5) * 128 + (F.vcu & 31))
#define GUE ((F.vcu >> 5) * 128 + 128)
    GrpBarrier gbar; gbar.w = (unsigned*)(F.ctl + CW_GRP) + 64 * (F.vcu >> 5); gbar.bar = (unsigned*)(F.ctl + CW_BAR); gbar.st = F.MISC + 10;
    if (N_LAUNCHES == 1) grp_barrier_post(gbar);
    const int lo = args.ph_lo, hi = args.ph_hi;
#define IN(k) (lo <= (k) && (k) < hi)
#define SEAM0(k) do { if (IN(k) && IN((k) + 1)) { xcd_barrier(bar); } } while (0)
#define SEAM(k) do { if (IN(k) && IN((k) + 1)) { grp_barrier(gbar); if (PROBE_DUP == 7) grp_barrier(gbar); } } while (0)
    if (IN(0)) { p0_prologue(F); if (PROBE_DUP == 1) p0_prologue(F); } SEAM0(0);
    for (int l = 0; l < NLAYER; ++l) {
        const int p0 = 1 + 5 * l;
        if (IN(p0)) {
            pg8::Gemm g{F.XB, F.Win_t + (size_t)l * NPROJ * 1024, M, 1792, DM}; pg8::StaticOrder S; S.init(M, 1792, F.G, (int)blockIdx.x);
            pg8::EpiInProj E{F.PROJ, l, 1};
            { F.refresh(); LAS float* gl = (LAS float*)(F.lds + AUX_OFF + 2048);
              if (F.tid < 256) { const float* src = (F.tid < 64 ? F.a_qn : F.tid < 128 ? F.a_kn : F.tid < 192 ? F.c_qn : F.c_kn) + l * 64 + (F.tid & 63); gl[F.tid] = *src; }
              { LAS float* cwl = (LAS float*)(F.lds + AUX_OFF + 4096); for (int i = F.tid; i < 768; i += NWAVES * 64) cwl[i] = F.conv_w[(size_t)l * 768 + i]; }
              __syncthreads(); }
            if (PROBE_DUP == 8) { pg8::EpiPlain E2{F.PROJ, NPROJ}; pg8::gemm_phase<pg8::EpiPlain, pg8::StaticOrder, true, true>(F.lds + RING_OFF, F.lds + AUX_OFF, g, S, E2); }
            if (PROBE_DUP == 9) { pg8::EpiNull E2{}; pg8::gemm_phase<pg8::EpiNull, pg8::StaticOrder, true, true>(F.lds + RING_OFF, F.lds + AUX_OFF, g, S, E2); }
            if (STAGGER_IN > 0) { const unsigned long long t0 = rt(); const unsigned long long dl = (unsigned long long)((F.vcu & 3) * STAGGER_IN); while (rt() - t0 < dl) __builtin_amdgcn_s_sleep(8); }
#if IN_ONE_CALL
            { pg8::Gemm ga{F.XB, F.Win_t + (size_t)l * NPROJ * 1024, M, NPROJ, DM}; pg8::StaticOrder Sa; Sa.init(M, NPROJ, F.G, (int)blockIdx.x); pg8::EpiInAll Ea{F.PROJ, l, 1};
              pg8::gemm_phase<pg8::EpiInAll, pg8::StaticOrder, true, true>(F.lds + RING_OFF, F.lds + AUX_OFF, ga, Sa, Ea); }
#else
            pg8::gemm_phase<pg8::EpiInProj, pg8::StaticOrder, true, true>(F.lds + RING_OFF, F.lds + AUX_OFF, g, S, E);
            { pg8::Gemm gp{F.XB, F.Win_t + (size_t)l * NPROJ * 1024 + (size_t)1792 * 1024, M, 1536, DM}; pg8::StaticOrder Sp; Sp.init(M, 1536, F.G, (int)blockIdx.x); pg8::EpiPoolConv Ep{F.PROJ, l};
              for (int rep = 0; rep < (PROBE_DUP == 14 ? 2 : 1); ++rep) pg8::gemm_phase<pg8::EpiPoolConv, pg8::StaticOrder, true, true>(F.lds + RING_OFF, F.lds + AUX_OFF, gp, Sp, Ep); }
#endif
            if (PROBE_DUP == 2) { pg8::EpiInProj E2 = E; E2.do_km = 0; pg8::gemm_phase<pg8::EpiInProj, pg8::StaticOrder, true, true>(F.lds + RING_OFF, F.lds + AUX_OFF, g, S, E2); }
        }
        SEAM(p0);
        if (IN(p0 + 1)) { F.refresh();
            moba_body::select_phase((char*)lds + SCR_OFF, F.PROJ, F.kmean + (size_t)l * 65536, F.cnt + (size_t)l * 32768, F.lst, GU0, 32, GUE);
            for (int rep = 0; rep < (PROBE_DUP == 4 ? 2 : 1); ++rep) moba_body::swa_phase((char*)lds + RING_OFF, (char*)lds + SCR_OFF, F.PROJ, F.c_sinks + l * 4, F.Y, GU0, 32, GUE); }
        SEAM(p0 + 1);
        if (IN(p0 + 2)) { F.refresh();
            for (int rep = 0; rep < (PROBE_DUP == 11 ? 2 : 1); ++rep) moba_body::gather_phase((char*)lds + RING_OFF, (char*)lds + SCR_OFF, F.PROJ, F.cnt + (size_t)l * 32768, F.lst, F.partO, F.partL, F.vcu);
        }
        SEAM(p0 + 2);
        if (IN(p0 + 3)) { F.refresh();
            for (int rep = 0; rep < (PROBE_DUP == 12 ? 2 : 1); ++rep) moba_body::own_merge_phase((char*)lds + RING_OFF, (char*)lds + SCR_OFF, F.PROJ, F.partO, F.partL, F.Y, GU0, 32, GUE);
            convfix_phase(F, l); poolfix_phase(F, l); }
        SEAM(p0 + 3);
        if (IN(p0 + 4)) {
            pg8::Gemm g{F.Y, F.Wout_t + (size_t)l * 1024 * 1024, M, DM, DM}; pg8::StaticOrder S; S.init(M, DM, F.G, (int)blockIdx.x);
            pg8::EpiOutProj E{F.XB, l == 0 ? nullptr : F.out, l == 0 ? F.XB : nullptr, F.ssq2};
            if (PROBE_DUP == 10) { pg8::EpiNull E2{}; pg8::gemm_phase<pg8::EpiNull, pg8::StaticOrder, true, true>(F.lds + RING_OFF, F.lds + AUX_OFF, g, S, E2); }
            if (PROBE_DUP == 6) { pg8::EpiOutProj E2{F.XB, (float*)F.partO, nullptr, F.ssq2}; pg8::gemm_phase<pg8::EpiOutProj, pg8::StaticOrder, true, true>(F.lds + RING_OFF, F.lds + AUX_OFF, g, S, E2); }
            if (STAGGER_OUT > 0) { const unsigned long long t0 = rt(); const unsigned long long dl = (unsigned long long)((F.vcu & 3) * STAGGER_OUT); while (rt() - t0 < dl) __builtin_amdgcn_s_sleep(8); }
            pg8::gemm_phase<pg8::EpiOutProj, pg8::StaticOrder, true, true>(F.lds + RING_OFF, F.lds + AUX_OFF, g, S, E);
        }
        if (l + 1 < NLAYER) SEAM(p0 + 4);
    }
#undef IN
#undef SEAM
#undef SEAM0
#undef GU0
#undef GUE
}
extern "C" void kernel_launch(void* const* d_in, const int* in_sizes, int n_in, void* d_out, int out_size, void* d_ws, size_t ws_size, hipStream_t stream) {
    static int grid = 0;
    if (grid == 0) {
        if (n_in != 12 || in_sizes[0] != M * DM || out_size != M * DM || ws_size < WS_END) { fprintf(stderr, "kernel_launch: unexpected shapes (n_in %d, in0 %d, out %d, ws %zu); nothing launched\n", n_in, n_in > 0 ? in_sizes[0] : -1, out_size, ws_size); grid = -1; return; }
        int dev = 0, cus = 0;
        if (hipGetDevice(&dev) != hipSuccess || hipDeviceGetAttribute(&cus, hipDeviceAttributeMultiprocessorCount, dev) != hipSuccess) { grid = -1; return; }
        if (hipFuncSetAttribute((const void*)hybrid_fwd, hipFuncAttributeMaxDynamicSharedMemorySize, LDS_BYTES) != hipSuccess) { fprintf(stderr, "kernel_launch: hipFuncSetAttribute failed\n"); grid = -1; return; }
        (void)hipGetLastError();
        if (cus < 256) { fprintf(stderr, "kernel_launch: %d CUs (256 needed: eight groups of 32 resident workgroups); nothing launched\n", cus); grid = -1; return; }
        grid = 256;
    }
    if (grid < 0) return;
    if (hipMemsetAsync((char*)d_ws + WS_CTL, 0, 64 * 1024, stream) != hipSuccess) return;
    Args a{};
    for (int i = 0; i < 12; ++i) a.in[i] = (const float*)d_in[i];
    a.out = (float*)d_out; a.ws = (unsigned char*)d_ws;
    for (int li = 0; li < N_LAUNCHES; ++li) {
        a.ph_lo = (N_LAUNCHES == 1) ? 0 : li; a.ph_hi = (N_LAUNCHES == 1) ? N_PHASES : li + 1; a.li = li;
        hipLaunchKernelGGL(hybrid_fwd, dim3(grid), dim3(NWAVES * 64), LDS_BYTES, stream, a);
    }
}
```
